# Optimizing an MI355X kernel written in HIP

```python
import jax, jax.numpy as jnp
from jax import lax
import numpy as np

D_MODEL = 1024
BATCH = 8
SEQ = 4096
DEPTH = 2

GRID_W = 64
CTX_LEN = 256
N_MIXERS = 2
EPS = 1e-6
CHUNK = 128
A_WIDTH = 2 * D_MODEL
A_GROUPS = 8
A_GROUP_DIM = A_WIDTH // A_GROUPS
HEAD_DIM = 64
N_HEADS = D_MODEL // HEAD_DIM
N_KV_HEADS = 4
Q_PER_KV = N_HEADS // N_KV_HEADS
WINDOW = 128
BLOCK = 128
ROPE_THETA = 10000.0
N_FREQ = HEAD_DIM // 4
QKV_DIM = (N_HEADS + 2 * N_KV_HEADS) * HEAD_DIM
FFN_DIM = 2816
CONV_W = 3
N_LAYERS_A = (DEPTH + 1) // 2
N_LAYERS_B = DEPTH // 2

kernel_name = "hybrid_gmlp_swa_convglu_dit"


def rms_norm(x, g):
    xf = x.astype(jnp.float32)
    y = xf * lax.rsqrt(jnp.mean(xf * xf, axis=-1, keepdims=True) + EPS)
    return (y * g.astype(jnp.float32)).astype(x.dtype)


def layer_norm(x, g, b):
    xf = x.astype(jnp.float32)
    mu = jnp.mean(xf, axis=-1, keepdims=True)
    var = jnp.mean(jnp.square(xf - mu), axis=-1, keepdims=True)
    y = (xf - mu) * lax.rsqrt(var + EPS)
    return (y * g.astype(jnp.float32) + b.astype(jnp.float32)).astype(x.dtype)


def modulate(h, shift, scale):
    return h * (1 + scale) + shift


def chunk_mlp(h, w_in, ln_g, ln_b, w_s, b_s, w_out):
    bsz, n_tok, _ = h.shape
    z = jax.nn.gelu(h @ w_in)
    u, v = jnp.split(z, 2, axis=-1)
    v = layer_norm(v, ln_g, ln_b)
    v = v.reshape(bsz, n_tok // CHUNK, CHUNK, A_GROUPS, A_GROUP_DIM)
    s = jnp.einsum('gpq,bnqgc->bnpgc', w_s, v) + b_s.T[None, None, :, :, None]
    return (u * s.reshape(bsz, n_tok, A_WIDTH)) @ w_out


def axial_rope_tables(n_tok):
    ROWS = n_tok // GRID_W
    row = jnp.repeat(jnp.arange(ROWS), GRID_W).astype(jnp.float32)
    col = jnp.tile(jnp.arange(GRID_W), ROWS).astype(jnp.float32)
    inv_freq = ROPE_THETA ** (-(jnp.arange(N_FREQ, dtype=jnp.float32) / N_FREQ))
    ang = jnp.concatenate([row[:, None] * inv_freq, col[:, None] * inv_freq], axis=-1)
    return jnp.cos(ang), jnp.sin(ang)


def apply_rope(x, cos, sin):
    shape = (1, cos.shape[0]) + (1,) * (x.ndim - 3) + (cos.shape[-1],)
    c = cos.reshape(shape).astype(x.dtype)
    s = sin.reshape(shape).astype(x.dtype)
    x1, x2 = jnp.split(x, 2, axis=-1)
    return jnp.concatenate([x1 * c - x2 * s, x2 * c + x1 * s], axis=-1)


def qkv_heads(h, w_qkv, b_qkv):
    bsz, n_tok, _ = h.shape
    qkv = h @ w_qkv + b_qkv
    q, k, v = jnp.split(qkv, [N_HEADS * HEAD_DIM, (N_HEADS + N_KV_HEADS) * HEAD_DIM], axis=-1)
    q = q.reshape(bsz, n_tok, N_KV_HEADS, Q_PER_KV, HEAD_DIM)
    k = k.reshape(bsz, n_tok, N_KV_HEADS, HEAD_DIM)
    v = v.reshape(bsz, n_tok, N_KV_HEADS, HEAD_DIM)
    return q, k, v


def softmax_with_sink(logits, sink):
    sink_col = jnp.broadcast_to(sink.astype(jnp.float32)[None, :, :, None, None], logits.shape[:-1] + (1,))
    p = jax.nn.softmax(jnp.concatenate([logits, sink_col], axis=-1), axis=-1)
    return p[..., :-1]


def window_attention(h, hc, w_qkv, b_qkv, sink, w_o, cos, sin, with_ctx_out):
    bsz, n_tok, _ = h.shape
    scale = HEAD_DIM ** -0.5
    sink = sink.reshape(N_KV_HEADS, Q_PER_KV)
    q, k, v = qkv_heads(h, w_qkv, b_qkv)
    qc, kc, vc = qkv_heads(hc, w_qkv, b_qkv)
    q = apply_rope(q, cos, sin)
    k = apply_rope(k, cos, sin)

    n_blk = n_tok // BLOCK
    band = 3 * BLOCK
    pad = ((0, 0), (BLOCK, BLOCK), (0, 0), (0, 0))
    kp = jnp.pad(k, pad)
    vp = jnp.pad(v, pad)
    qb = jnp.moveaxis(q.reshape(bsz, n_blk, BLOCK, N_KV_HEADS, Q_PER_KV, HEAD_DIM), 1, 0)
    rel = jnp.arange(BLOCK)[:, None] - jnp.arange(band)[None, :] + BLOCK
    in_window = jnp.abs(rel) <= WINDOW

    def one_block(args):
        j, qj = args
        kj = lax.dynamic_slice_in_dim(kp, j * BLOCK, band, axis=1)
        vj = lax.dynamic_slice_in_dim(vp, j * BLOCK, band, axis=1)
        kpos = j * BLOCK - BLOCK + jnp.arange(band)
        valid = in_window & ((kpos >= 0) & (kpos < n_tok))[None, :]
        s_lat = jnp.einsum('bqhgd,bkhd->bhgqk', qj, kj).astype(jnp.float32) * scale
        s_lat = jnp.where(valid, s_lat, -jnp.inf)
        s_ctx = jnp.einsum('bqhgd,bkhd->bhgqk', qj, kc).astype(jnp.float32) * scale
        p = softmax_with_sink(jnp.concatenate([s_lat, s_ctx], axis=-1), sink)
        p_lat = p[..., :band].astype(vj.dtype)
        p_ctx = p[..., band:].astype(vc.dtype)
        return (jnp.einsum('bhgqk,bkhd->bqhgd', p_lat, vj)
                + jnp.einsum('bhgqk,bkhd->bqhgd', p_ctx, vc))

    out = lax.map(one_block, (jnp.arange(n_blk), qb))
    y = jnp.moveaxis(out, 0, 1).reshape(bsz, n_tok, N_HEADS * HEAD_DIM) @ w_o

    if not with_ctx_out:
        return y, None
    s_cc = jnp.einsum('bqhgd,bkhd->bhgqk', qc, kc).astype(jnp.float32) * scale
    p_cc = softmax_with_sink(s_cc, sink).astype(vc.dtype)
    yc = jnp.einsum('bhgqk,bkhd->bqhgd', p_cc, vc).reshape(bsz, hc.shape[1], N_HEADS * HEAD_DIM) @ w_o
    return y, yc


def conv_ffn(h, w_up, conv_w, conv_b, w_down):
    a, b = jnp.split(h @ w_up, 2, axis=-1)
    ap = jnp.pad(a, ((0, 0), (1, 1), (0, 0)))
    a = ap[:, :-2] * conv_w[0] + ap[:, 1:-1] * conv_w[1] + ap[:, 2:] * conv_w[2] + conv_b
    return (jax.nn.gelu(a) * b) @ w_down


def setup_inputs(seed: int = 0) -> dict:
    key = jax.random.key(seed)
    ks = jax.random.split(key, 24)
    n = lambda k, shape: jax.random.normal(k, shape, jnp.float32)
    D, E, F = D_MODEL, A_WIDTH, FFN_DIM
    return {
        "x": n(ks[0], (BATCH, SEQ, D)),
        "c": n(ks[1], (BATCH, D)),
        "ctx": n(ks[2], (BATCH, CTX_LEN, D)),
        "c_ctx": n(ks[3], (D,)),
        "ada_w": n(ks[4], (DEPTH, D, 6 * D)) * (0.5 * D ** -0.5),
        "ada_b": n(ks[5], (DEPTH, 6 * D)) * 0.01,
        "norm_g": 1.0 + 0.05 * n(ks[6], (DEPTH, 4, D)),
        "a_w_in": n(ks[7], (N_LAYERS_A, D, 2 * E)) * D ** -0.5,
        "a_ln_g": 1.0 + 0.05 * n(ks[8], (N_LAYERS_A, E)),
        "a_ln_b": 0.02 * n(ks[9], (N_LAYERS_A, E)),
        "a_w_s": n(ks[10], (N_LAYERS_A, A_GROUPS, CHUNK, CHUNK)) * CHUNK ** -0.5,
        "a_b_s": 1.0 + 0.05 * n(ks[11], (N_LAYERS_A, A_GROUPS, CHUNK)),
        "a_w_out": n(ks[12], (N_LAYERS_A, E, D)) * E ** -0.5,
        "b_w_qkv": n(ks[13], (N_LAYERS_B, D, QKV_DIM)) * D ** -0.5,
        "b_b_qkv": 0.02 * n(ks[14], (N_LAYERS_B, QKV_DIM)),
        "b_sink": n(ks[15], (N_LAYERS_B, N_HEADS)),
        "b_w_o": n(ks[16], (N_LAYERS_B, N_HEADS * HEAD_DIM, D)) * (N_HEADS * HEAD_DIM) ** -0.5,
        "f_w_up": n(ks[17], (DEPTH, D, 2 * F)) * D ** -0.5,
        "f_conv_w": n(ks[18], (DEPTH, CONV_W, F)) * CONV_W ** -0.5,
        "f_conv_b": 0.02 * n(ks[19], (DEPTH, F)),
        "f_w_down": n(ks[20], (DEPTH, F, D)) * F ** -0.5,
    }


def reference(x, c, ctx, c_ctx, ada_w, ada_b, norm_g, a_w_in, a_ln_g, a_ln_b, a_w_s, a_b_s,
              a_w_out, b_w_qkv, b_b_qkv, b_sink, b_w_o, f_w_up, f_conv_w, f_conv_b, f_w_down):
    n_tok = x.shape[1]
    cos, sin = axial_rope_tables(n_tok)
    silu_c = jax.nn.silu(c)
    silu_cc = jax.nn.silu(c_ctx)
    for i in range(DEPTH):
        last = i == DEPTH - 1
        mod_lat = (silu_c @ ada_w[i] + ada_b[i])[:, None, :]
        mod_ctx = (silu_cc @ ada_w[i] + ada_b[i])[None, None, :]
        sh1, sc1, g1, sh2, sc2, g2 = jnp.split(mod_lat, 6, axis=-1)
        csh1, csc1, cg1, csh2, csc2, cg2 = jnp.split(mod_ctx, 6, axis=-1)

        h = modulate(rms_norm(x, norm_g[i, 0]), sh1, sc1)
        hc = modulate(rms_norm(ctx, norm_g[i, 0]), csh1, csc1)
        j = i // N_MIXERS
        if i % N_MIXERS == 0:
            y = chunk_mlp(h, a_w_in[j], a_ln_g[j], a_ln_b[j], a_w_s[j], a_b_s[j], a_w_out[j])
            yc = None if last else chunk_mlp(hc, a_w_in[j], a_ln_g[j], a_ln_b[j], a_w_s[j], a_b_s[j], a_w_out[j])
        else:
            y, yc = window_attention(h, hc, b_w_qkv[j], b_b_qkv[j], b_sink[j], b_w_o[j], cos, sin, not last)
        x = x + g1 * rms_norm(y, norm_g[i, 1])
        if not last:
            ctx = ctx + cg1 * rms_norm(yc, norm_g[i, 1])

        h = modulate(rms_norm(x, norm_g[i, 2]), sh2, sc2)
        x = x + g2 * rms_norm(conv_ffn(h, f_w_up[i], f_conv_w[i], f_conv_b[i], f_w_down[i]), norm_g[i, 3])
        if not last:
            hc = modulate(rms_norm(ctx, norm_g[i, 2]), csh2, csc2)
            ctx = ctx + cg2 * rms_norm(conv_ffn(hc, f_w_up[i], f_conv_w[i], f_conv_b[i], f_w_down[i]), norm_g[i, 3])
    return x
```

```cpp
#include <hip/hip_runtime.h>
#include <hip/hip_cooperative_groups.h>
#include <cstdio>
#include <cstdint>
namespace cg = cooperative_groups;

#ifndef MK_PER_PHASE_LAUNCH
#define MK_PER_PHASE_LAUNCH 0
#endif

#define LAS __attribute__((address_space(3)))
typedef unsigned short bf16_t;
typedef short bf16x8 __attribute__((ext_vector_type(8)));
typedef short s16x4 __attribute__((ext_vector_type(4)));
typedef float f32x4 __attribute__((ext_vector_type(4)));
typedef float f32x2 __attribute__((ext_vector_type(2)));
typedef unsigned u32x4 __attribute__((ext_vector_type(4)));
typedef unsigned u32x2 __attribute__((ext_vector_type(2)));

constexpr int D = 1024, BATCH = 8, SEQ = 4096, CTXL = 256;
constexpr int MLAT = BATCH * SEQ, MCTX = BATCH * CTXL, MALL = MLAT + MCTX;
constexpr int EW = 2048, FF = 2816, QKVD = 1536;
constexpr float EPS = 1e-6f;
constexpr float LOG2E = 1.4426950408889634f;

constexpr size_t MiB = 1u << 20;
constexpr size_t WS_MODV = 0;
constexpr size_t WS_ROPEC = 1 * MiB;
constexpr size_t WS_ROPES = WS_ROPEC + 512 * 1024;
constexpr size_t WS_BIASP = 2 * MiB;
constexpr size_t WS_WS = 2 * MiB + 64 * 1024;
constexpr size_t WS_STATS = 3 * MiB;
constexpr size_t WS_CTX = 12 * MiB;
constexpr size_t WS_WIN = 20 * MiB;
constexpr size_t WS_WOUT = 28 * MiB;
constexpr size_t WS_WQKV = 32 * MiB;
constexpr size_t WS_WO = 35 * MiB;
constexpr size_t WS_WUP = 37 * MiB;
constexpr size_t WS_WDN = 48 * MiB;
constexpr size_t WS_YH = 54 * MiB;
constexpr size_t WS_BIG = 122 * MiB;
constexpr size_t WS_OBUF = WS_BIG + 104 * MiB;
constexpr size_t WS_END = WS_BIG + (size_t)MALL * 5632 * 2;
static_assert(WS_END <= 512 * MiB, "ws map");

constexpr int LDS_BYTES = 147456;

__device__ __forceinline__ unsigned cvt_pk_bf16(float lo, float hi) { unsigned r; asm("v_cvt_pk_bf16_f32 %0, %1, %2" : "=v"(r) : "v"(lo), "v"(hi)); return r; }
__device__ __forceinline__ float bf_lo(unsigned w) { return __uint_as_float(w << 16); }
__device__ __forceinline__ float bf_hi(unsigned w) { return __uint_as_float(w & 0xffff0000u); }
__device__ __forceinline__ float wave_sum(float v) {
#pragma unroll
    for (int o = 1; o < 64; o <<= 1) v += __shfl_xor(v, o);
    return v;
}
__device__ __forceinline__ float gelu_t(float x) {
    const float u = x * (0.7978845608f + 0.0356774081f * x * x);
    const float e = __builtin_amdgcn_exp2f(-2.885390082f * u);
    return x * __builtin_amdgcn_rcpf(1.0f + e);
}
__device__ __forceinline__ int qkv_dst_row(int c) {
    if (c >= 1280) return c;
    const int head = c >> 6, d = c & 63;
    const int p = (d < 32) ? (8 * (d >> 2) + (d & 3)) : (8 * ((d - 32) >> 2) + 4 + (d & 3));
    return head * 64 + p;
}

namespace pg8 {
constexpr int BM = 256, BK = 64, HALF = 128, HTB = HALF * BK * 2, STAGE_BYTES = 8 * HTB, NXCD = 8, WGM = 8;
__host__ __device__ __forceinline__ int lds_byte(int r, int c) { const int st = (r >> 4) * 2 + (c >> 5), rr = r & 15, cc = c & 31, ob = rr * 64 + cc * 2; return st * 1024 + (ob ^ (((ob >> 9) & 1) << 5)); }
__host__ __device__ __forceinline__ void stage_rc(int b, int& R, int& C) { const int st = b / 1024, sb = b % 1024, swz = sb ^ (((sb >> 9) & 1) << 5); R = (st >> 1) * 16 + swz / 64; C = (st & 1) * 32 + (swz % 64) / 2; }
__host__ __device__ __forceinline__ int perm32(int rho) { const int n = rho >> 4, i = rho & 15; return 8 * (i >> 2) + 4 * n + (i & 3); }

struct Unit { int pm, pn; };
struct Gemm { const bf16_t* A; int lda; const bf16_t* Bt; int M, N, K; };

struct StaticOrder {
    int nM, nN, nwg, G, c;
    __host__ __device__ void init(int M, int N, int G_, int c_) { nM = M / BM; nN = N / BM; nwg = nM * nN; G = G_; c = c_; }
    __host__ __device__ bool next(int i, Unit& u) const {
        const long L = (long)i * G + c; if (L >= nwg) return false;
        int wgid = (int)L; { const int q = nwg / NXCD, r = nwg % NXCD, xcd = wgid % NXCD, off = wgid / NXCD; wgid = (xcd < r ? xcd * (q + 1) : r * (q + 1) + (xcd - r) * q) + off; }
        const int nig = WGM * nN, gid = wgid / nig, fm = gid * WGM, gsz = (nM - fm) < WGM ? (nM - fm) : WGM;
        u.pm = fm + ((wgid % nig) % gsz); u.pn = (wgid % nig) / gsz; return true;
    }
};

template <int MODE> struct Epi {
    static constexpr bool PERM = true;
    bf16_t* O; int ldc; f32x2* stats; const float* bias; const float* ropec; const float* ropes;
    __device__ __forceinline__ void operator()(const f32x4 (&acc)[2][2][4][2], const Unit& u, int wr, int wc, int fr, int fq) const {
        const int row0 = u.pm * BM + wr * 64 + fr, colt = u.pn * BM + wc * 32 + 8 * fq;
        f32x4 bv[2][2];
        if (MODE == 3) {
#pragma unroll
            for (int bj = 0; bj < 2; ++bj)
#pragma unroll
                for (int n = 0; n < 2; ++n) bv[bj][n] = *(const f32x4*)(bias + colt + bj * HALF + 4 * n);
        }
        const bool do_stats = (MODE == 2) || (MODE == 1 && u.pn >= 8);
        const int sidx = (MODE == 1 ? (u.pn - 8) : u.pn) * 4 + wc;
#pragma unroll
        for (int ai = 0; ai < 2; ++ai)
#pragma unroll
            for (int m = 0; m < 4; ++m) {
                const int row = row0 + ai * HALF + m * 16;
                bf16_t* rowp = O + (size_t)row * ldc + colt;
                float s = 0.f, q = 0.f;
                f32x4 rc, rs;
                const bool do_rope = (MODE == 3) && (u.pn < 5) && (row < MLAT);
                if (MODE == 3) {
                    if (do_rope) { const int pos = row & (SEQ - 1), mm = (wc & 1) * 4 + fq; rc = *(const f32x4*)(ropec + pos * 32 + 4 * mm); rs = *(const f32x4*)(ropes + pos * 32 + 4 * mm); }
                    else { rc = (f32x4){1.f, 1.f, 1.f, 1.f}; rs = (f32x4){0.f, 0.f, 0.f, 0.f}; }
                }
#pragma unroll
                for (int bj = 0; bj < 2; ++bj) {
                    f32x4 v0 = acc[ai][bj][m][0], v1 = acc[ai][bj][m][1];
                    if (MODE == 1) {
#pragma unroll
                        for (int j = 0; j < 4; ++j) { v0[j] = gelu_t(v0[j]); v1[j] = gelu_t(v1[j]); }
                    }
                    if (MODE == 3) {
                        v0 += bv[bj][0]; v1 += bv[bj][1];
                        const f32x4 x1 = v0, x2 = v1;
                        v0 = x1 * rc - x2 * rs; v1 = x2 * rc + x1 * rs;
                        if (u.pn < 4) { v0 *= 0.125f; v1 *= 0.125f; }
                    }
                    if (MODE == 1 || MODE == 2) {
#pragma unroll
                        for (int j = 0; j < 4; ++j) { s += v0[j] + v1[j]; q += v0[j] * v0[j] + v1[j] * v1[j]; }
                    }
                    u32x4 w; w.x = cvt_pk_bf16(v0[0], v0[1]); w.y = cvt_pk_bf16(v0[2], v0[3]); w.z = cvt_pk_bf16(v1[0], v1[1]); w.w = cvt_pk_bf16(v1[2], v1[3]);
                    *(u32x4*)(rowp + bj * HALF) = w;
                }
                if (MODE == 1 || MODE == 2) {
                    s += __shfl_xor(s, 16); s += __shfl_xor(s, 32); q += __shfl_xor(q, 16); q += __shfl_xor(q, 32);
                    if (do_stats && fq == 0) stats[(size_t)row * 32 + sidx] = (f32x2){s, q};
                }
            }
    }
};

template <class EpiT, bool ALIGN_EPI, bool SP2>
__device__ __forceinline__ void gemm_phase(LAS unsigned char* lds, const Gemm g, const StaticOrder& S, const EpiT& E) {
    const int tid = threadIdx.x, wid = __builtin_amdgcn_readfirstlane(tid >> 6), lane = tid & 63, wr = wid >> 2, wc = wid & 3, fr = lane & 15, fq = lane >> 4;
    const int K = g.K, nt = K / BK, lda = g.lda;
    unsigned voffA[2], voffB[2];
#pragma unroll
    for (int i = 0; i < 2; ++i) { int R, C; stage_rc(tid * 16 + i * 8192, R, C); const int Rb = EpiT::PERM ? ((R & ~31) + perm32(R & 31)) : R;
        voffA[i] = (unsigned)(R * lda + C) * 2u; voffB[i] = (unsigned)(Rb * K + C) * 2u; }
    const size_t kstep = (size_t)(BK * 2);
    const size_t hA = (size_t)HALF * lda * 2, hB = (size_t)HALF * K * 2;
    const size_t tA = 2 * hA, tB = 2 * hB;
    const unsigned ldsw = (unsigned)wid * 1024u;
    const int aoff = lds_byte(wr * 64 + fr, fq * 8), boff = lds_byte(wc * 32 + fr, fq * 8);
#define PG8_SA(b, h) (((b) * 2 + (h)) * HTB)
#define PG8_SB(b, h) ((4 + (b) * 2 + (h)) * HTB)
#define PG8_STAGE(bufoff, gbase, voff) do { _Pragma("unroll") for (int _i = 0; _i < 2; ++_i) \
        __builtin_amdgcn_global_load_lds((const unsigned*)((const char*)(gbase) + (voff)[_i]), (LAS unsigned*)(lds + (bufoff) + ldsw + _i * 8192), 16, 0, 0); } while (0)
#define PG8_LDA(dst, b, h) do { _Pragma("unroll") for (int m = 0; m < 4; ++m) _Pragma("unroll") for (int k = 0; k < 2; ++k) dst[m][k] = *(const LAS bf16x8*)(lds + PG8_SA(b, h) + aoff + m * 2048 + k * 1024); } while (0)
#define PG8_LDB(dst, b, h) do { _Pragma("unroll") for (int n = 0; n < 2; ++n) _Pragma("unroll") for (int k = 0; k < 2; ++k) dst[n][k] = *(const LAS bf16x8*)(lds + PG8_SB(b, h) + boff + n * 2048 + k * 1024); } while (0)
#define PG8_MMA(ai, bj, At, Bt) do { __builtin_amdgcn_s_setprio(1); _Pragma("unroll") for (int m = 0; m < 4; ++m) _Pragma("unroll") for (int n = 0; n < 2; ++n) _Pragma("unroll") for (int k = 0; k < 2; ++k) \
        acc[ai][bj][m][n] = __builtin_amdgcn_mfma_f32_16x16x32_bf16(Bt[n][k], At[m][k], acc[ai][bj][m][n], 0, 0, 0); __builtin_amdgcn_s_setprio(0); } while (0)
#define PG8_WAIT_V(n) asm volatile("s_waitcnt vmcnt(" #n ")" ::: "memory")
#define PG8_WAIT_L(n) asm volatile("s_waitcnt lgkmcnt(" #n ")" ::: "memory")
#define PG8_BAR __builtin_amdgcn_s_barrier()
#define PG8_SCHED __builtin_amdgcn_sched_barrier(0)
    Unit cur, nxt; int ui = 0;
    if (!S.next(0, cur)) return;
    f32x4 acc[2][2][4][2];
#pragma unroll
    for (int a = 0; a < 2; ++a)
#pragma unroll
        for (int b = 0; b < 2; ++b)
#pragma unroll
            for (int m = 0; m < 4; ++m)
#pragma unroll
                for (int n = 0; n < 2; ++n) acc[a][b][m][n] = (f32x4){0.f, 0.f, 0.f, 0.f};
    bf16x8 At[4][2], B0[2][2], B1[2][2];
    const char* cA = (const char*)g.A + (size_t)cur.pm * tA; const char* cB = (const char*)g.Bt + (size_t)cur.pn * tB;
    if constexpr (SP2) {
        PG8_STAGE(PG8_SB(0, 0), cB, voffB); PG8_STAGE(PG8_SB(0, 1), cB + hB, voffB); PG8_STAGE(PG8_SA(0, 0), cA, voffA); PG8_STAGE(PG8_SA(0, 1), cA + hA, voffA);
        if (wr == 1) PG8_BAR;
        PG8_WAIT_V(2); PG8_BAR;
        PG8_STAGE(PG8_SB(1, 0), cB + kstep, voffB); PG8_STAGE(PG8_SA(1, 0), cA + kstep, voffA); PG8_STAGE(PG8_SB(1, 1), cB + hB + kstep, voffB);
        PG8_WAIT_V(6); PG8_BAR;
    } else {
        PG8_STAGE(PG8_SB(0, 0), cB, voffB); PG8_STAGE(PG8_SA(0, 0), cA, voffA); PG8_STAGE(PG8_SB(0, 1), cB + hB, voffB); PG8_STAGE(PG8_SA(0, 1), cA + hA, voffA);
        if (wr == 1) PG8_BAR;
        PG8_WAIT_V(4); PG8_BAR;
        PG8_STAGE(PG8_SB(1, 0), cB + kstep, voffB); PG8_STAGE(PG8_SA(1, 0), cA + kstep, voffA); PG8_STAGE(PG8_SB(1, 1), cB + hB + kstep, voffB);
        PG8_WAIT_V(6); PG8_BAR;
    }
    for (;;) {
        const bool has_next = S.next(ui + 1, nxt);
        const char* nA = has_next ? (const char*)g.A + (size_t)nxt.pm * tA : cA; const char* nB = has_next ? (const char*)g.Bt + (size_t)nxt.pn * tB : cB;
        for (int t = 0; t < nt; t += 2) {
            const bool last = (t == nt - 2);
            const char* a1 = cA + (size_t)(t + 1) * kstep;
            const char* a2 = last ? nA : cA + (size_t)(t + 2) * kstep; const char* b2 = last ? nB : cB + (size_t)(t + 2) * kstep;
            const char* a3 = a2 + kstep; const char* b3 = b2 + kstep;
            if constexpr (SP2) {
            PG8_LDB(B0, 0, 0); PG8_LDB(B1, 0, 1); PG8_SCHED; PG8_LDA(At, 0, 0); PG8_STAGE(PG8_SA(1, 1), a1 + hA, voffA);
            PG8_WAIT_V(8); PG8_WAIT_L(0); PG8_BAR; PG8_MMA(0, 0, At, B0); PG8_MMA(0, 1, At, B1); PG8_BAR; PG8_SCHED;
            PG8_LDA(At, 0, 1); PG8_STAGE(PG8_SB(0, 0), b2, voffB); PG8_STAGE(PG8_SB(0, 1), b2 + hB, voffB); PG8_STAGE(PG8_SA(0, 0), a2, voffA);
            PG8_WAIT_V(8); PG8_WAIT_L(0); PG8_BAR; PG8_MMA(1, 0, At, B0); PG8_MMA(1, 1, At, B1); PG8_BAR; PG8_SCHED;
            PG8_LDB(B0, 1, 0); PG8_LDB(B1, 1, 1); PG8_SCHED; PG8_LDA(At, 1, 0); PG8_STAGE(PG8_SA(0, 1), a2 + hA, voffA);
            PG8_WAIT_V(8); PG8_WAIT_L(0); PG8_BAR; PG8_MMA(0, 0, At, B0); PG8_MMA(0, 1, At, B1); PG8_BAR; PG8_SCHED;
            PG8_LDA(At, 1, 1); PG8_STAGE(PG8_SB(1, 0), b3, voffB); PG8_STAGE(PG8_SB(1, 1), b3 + hB, voffB); PG8_STAGE(PG8_SA(1, 0), a3, voffA);
            PG8_WAIT_V(8); PG8_WAIT_L(0); PG8_BAR; PG8_MMA(1, 0, At, B0); PG8_MMA(1, 1, At, B1); PG8_BAR; PG8_SCHED;
            } else {
            PG8_LDB(B0, 0, 0); PG8_SCHED; PG8_LDA(At, 0, 0); PG8_STAGE(PG8_SA(1, 1), a1 + hA, voffA);
            PG8_WAIT_L(8); PG8_BAR; PG8_WAIT_L(0); PG8_MMA(0, 0, At, B0); PG8_BAR; PG8_SCHED;
            PG8_LDB(B1, 0, 1); PG8_STAGE(PG8_SB(0, 0), b2, voffB);
            PG8_BAR; PG8_WAIT_L(0); PG8_MMA(0, 1, At, B1); PG8_BAR;
            PG8_LDA(At, 0, 1); PG8_STAGE(PG8_SA(0, 0), a2, voffA);
            PG8_BAR; PG8_WAIT_L(0); PG8_MMA(1, 0, At, B0); PG8_BAR; PG8_SCHED;
            PG8_STAGE(PG8_SB(0, 1), b2 + hB, voffB);
            PG8_WAIT_V(6); PG8_BAR; PG8_MMA(1, 1, At, B1); PG8_BAR;
            PG8_LDB(B0, 1, 0); PG8_SCHED; PG8_LDA(At, 1, 0); PG8_STAGE(PG8_SA(0, 1), a2 + hA, voffA);
            PG8_WAIT_L(8); PG8_BAR; PG8_WAIT_L(0); PG8_MMA(0, 0, At, B0); PG8_BAR; PG8_SCHED;
            PG8_LDB(B1, 1, 1); PG8_STAGE(PG8_SB(1, 0), b3, voffB);
            PG8_BAR; PG8_WAIT_L(0); PG8_MMA(0, 1, At, B1); PG8_BAR;
            PG8_LDA(At, 1, 1); PG8_STAGE(PG8_SA(1, 0), a3, voffA);
            PG8_BAR; PG8_WAIT_L(0); PG8_MMA(1, 0, At, B0); PG8_BAR; PG8_SCHED;
            PG8_STAGE(PG8_SB(1, 1), b3 + hB, voffB);
            PG8_WAIT_V(6); PG8_BAR; PG8_MMA(1, 1, At, B1); PG8_BAR;
            }
        }
        if constexpr (ALIGN_EPI) { if (wr == 0) PG8_BAR; }
        E(acc, cur, wr, wc, fr, fq);
        if (!has_next) break;
#pragma unroll
        for (int a = 0; a < 2; ++a)
#pragma unroll
            for (int b = 0; b < 2; ++b)
#pragma unroll
                for (int m = 0; m < 4; ++m)
#pragma unroll
                    for (int n = 0; n < 2; ++n) acc[a][b][m][n] = (f32x4){0.f, 0.f, 0.f, 0.f};
        cur = nxt; cA = nA; cB = nB; ++ui;
        if constexpr (ALIGN_EPI) { if (wr == 1) PG8_BAR; }
    }
    PG8_WAIT_V(0);
    if constexpr (!ALIGN_EPI) { if (wr == 0) PG8_BAR; }
    PG8_BAR;
#undef PG8_SA
#undef PG8_SB
#undef PG8_STAGE
#undef PG8_LDA
#undef PG8_LDB
#undef PG8_MMA
#undef PG8_WAIT_V
#undef PG8_WAIT_L
#undef PG8_BAR
#undef PG8_SCHED
}
}

struct Args { const float* in[21]; float* out; unsigned char* ws; int ph_lo, ph_hi; };
enum { I_X = 0, I_C, I_CTX, I_CCTX, I_ADAW, I_ADAB, I_NORMG, I_AWIN, I_ALNG, I_ALNB, I_AWS, I_ABS, I_AWOUT, I_BWQKV, I_BBQKV, I_BSINK, I_BWO, I_FWUP, I_FCONVW, I_FCONVB, I_FWDN };

__device__ __forceinline__ void transpose_item(const float* W, int K, int N, bf16_t* WT, bool perm, LAS float* scr, int item, int lane) {
    const int nblk = N / 32, kb = item / nblk, nb = item % nblk, k0 = 64 * kb, n0 = 32 * nb;
#pragma unroll 8
    for (int i = 0; i < 32; ++i) { const int kk = 2 * i + (lane >> 5); scr[kk * 33 + (lane & 31)] = W[(size_t)(k0 + kk) * N + n0 + (lane & 31)]; }
    asm volatile("s_waitcnt lgkmcnt(0)" ::: "memory");
    const int c = lane & 7;
#pragma unroll
    for (int j = 0; j < 4; ++j) { const int n = (lane >> 3) + 8 * j; const LAS float* s = scr + (8 * c) * 33 + n;
        u32x4 o; o.x = cvt_pk_bf16(s[0 * 33], s[1 * 33]); o.y = cvt_pk_bf16(s[2 * 33], s[3 * 33]); o.z = cvt_pk_bf16(s[4 * 33], s[5 * 33]); o.w = cvt_pk_bf16(s[6 * 33], s[7 * 33]);
        const int dr = perm ? qkv_dst_row(n0 + n) : (n0 + n);
        *(u32x4*)(WT + (size_t)dr * K + k0 + 8 * c) = o; }
    asm volatile("s_waitcnt lgkmcnt(0)" ::: "memory");
}

struct RowArgs {
    const float* xin_lat; const float* xin_ctx; float* xout_lat; float* xout_ctx;
    const bf16_t* Y; const f32x2* stats; const float* gmod; int gate_off; const float* ng_post;
    const float* ng_pre; const float* hmod; int sh_off, sc_off; bf16_t* H; int nrows;
};
__device__ __forceinline__ void row_phase(const RowArgs& A, int gw, int NGW, int lane) {
    for (int row = gw; row < A.nrows; row += NGW) {
        const bool lat = row < MLAT; const int bidx = lat ? (row >> 12) : 8;
        const float* xi = lat ? A.xin_lat + (size_t)row * D : A.xin_ctx + (size_t)(row - MLAT) * D;
        f32x4 x[4];
#pragma unroll
        for (int j = 0; j < 4; ++j) x[j] = *(const f32x4*)(xi + 4 * lane + 256 * j);
        if (A.Y) {
            float ss = (lane < 16) ? A.stats[(size_t)row * 32 + lane].y : 0.f; ss = wave_sum(ss);
            const float rstd = rsqrtf(ss * (1.0f / D) + EPS);
            const float* gate = A.gmod + bidx * 6144 + A.gate_off;
#pragma unroll
            for (int j = 0; j < 4; ++j) { const int col = 4 * lane + 256 * j;
                const u32x2 yw = *(const u32x2*)(A.Y + (size_t)row * D + col);
                const f32x4 y = (f32x4){bf_lo(yw.x), bf_hi(yw.x), bf_lo(yw.y), bf_hi(yw.y)};
                const f32x4 g4 = *(const f32x4*)(gate + col), n4 = *(const f32x4*)(A.ng_post + col);
                x[j] += g4 * (y * rstd * n4); }
            float* xo = lat ? A.xout_lat + (size_t)row * D : A.xout_ctx + (size_t)(row - MLAT) * D;
#pragma unroll
            for (int j = 0; j < 4; ++j) *(f32x4*)(xo + 4 * lane + 256 * j) = x[j];
        }
        if (A.H) {
            float s2 = 0.f;
#pragma unroll
            for (int j = 0; j < 4; ++j) s2 += (x[j][0] * x[j][0] + x[j][1] * x[j][1]) + (x[j][2] * x[j][2] + x[j][3] * x[j][3]);
            s2 = wave_sum(s2);
            const float rstd2 = rsqrtf(s2 * (1.0f / D) + EPS);
            const float* sh = A.hmod + bidx * 6144 + A.sh_off; const float* sc = A.hmod + bidx * 6144 + A.sc_off;
#pragma unroll
            for (int j = 0; j < 4; ++j) { const int col = 4 * lane + 256 * j;
                const f32x4 n4 = *(const f32x4*)(A.ng_pre + col), s4 = *(const f32x4*)(sh + col), c4 = *(const f32x4*)(sc + col);
                const f32x4 h = (x[j] * rstd2 * n4) * (c4 + 1.0f) + s4;
                u32x2 w; w.x = cvt_pk_bf16(h[0], h[1]); w.y = cvt_pk_bf16(h[2], h[3]);
                *(u32x2*)(A.H + (size_t)row * D + col) = w; }
        }
    }
}

__device__ __forceinline__ void conv_phase(bf16_t* AB, const float* cw, const float* cb, int nrows, int gtid, int nthreads) {
    constexpr int RUN = 16, NCH = FF / 8;
    const int total = (nrows / RUN) * NCH;
    for (int it = gtid; it < total; it += nthreads) {
        const int ch = it % NCH, run = it / NCH, r0 = run * RUN, c0 = ch * 8;
        const bool lat = r0 < MLAT; const int pos0 = lat ? (r0 & (SEQ - 1)) : ((r0 - MLAT) & (CTXL - 1)); const int L = lat ? SEQ : CTXL;
        float w0[8], w1[8], w2[8], bb[8];
#pragma unroll
        for (int h = 0; h < 2; ++h) { const f32x4 a = *(const f32x4*)(cw + c0 + 4 * h), b = *(const f32x4*)(cw + FF + c0 + 4 * h), c = *(const f32x4*)(cw + 2 * FF + c0 + 4 * h), d = *(const f32x4*)(cb + c0 + 4 * h);
#pragma unroll
            for (int j = 0; j < 4; ++j) { w0[4 * h + j] = a[j]; w1[4 * h + j] = b[j]; w2[4 * h + j] = c[j]; bb[4 * h + j] = d[j]; } }
        bf16_t* base = AB + (size_t)r0 * (2 * FF) + c0;
        u32x4 ap = (u32x4){0u, 0u, 0u, 0u}, ac, an;
        if (pos0 > 0) ap = *(const u32x4*)(base - 2 * FF);
        ac = *(const u32x4*)(base);
#pragma unroll 4
        for (int r = 0; r < RUN; ++r) {
            bf16_t* rp = base + (size_t)r * (2 * FF);
            an = (u32x4){0u, 0u, 0u, 0u};
            if (pos0 + r + 1 < L) an = *(const u32x4*)(rp + 2 * FF);
            const u32x4 bw = *(const u32x4*)(rp + FF);
            u32x4 o;
#pragma unroll
            for (int k = 0; k < 4; ++k) {
                const float c_lo = bf_lo(ap[k]) * w0[2 * k] + bf_lo(ac[k]) * w1[2 * k] + bf_lo(an[k]) * w2[2 * k] + bb[2 * k];
                const float c_hi = bf_hi(ap[k]) * w0[2 * k + 1] + bf_hi(ac[k]) * w1[2 * k + 1] + bf_hi(an[k]) * w2[2 * k + 1] + bb[2 * k + 1];
                o[k] = cvt_pk_bf16(gelu_t(c_lo) * bf_lo(bw[k]), gelu_t(c_hi) * bf_hi(bw[k]));
            }
            *(u32x4*)(rp + FF) = o;
            ap = ac; ac = an;
        }
    }
}

__device__ __forceinline__ void sgate_phase(LAS unsigned char* lds, bf16_t* Z, const f32x2* stats, const bf16_t* wsb, const float* b_s, const float* ln_g, const float* ln_b, int G, int c) {
    constexpr int VS = 528, WSs = 272, VT_OFF = 0, WT_OFF = 128 * VS;
    const int tid = threadIdx.x, lane = tid & 63, w = __builtin_amdgcn_readfirstlane(tid >> 6), l15 = lane & 15, g4 = lane >> 4, qq = l15 >> 2, pp = l15 & 3;
    const int cc = tid & 31;
    for (int item = c; item < (MALL / 128) * 8; item += G) {
        const int chunk = item >> 3, g = item & 7;
        __syncthreads();
#pragma unroll
        for (int i = 0; i < 4; ++i) { const int id = tid + 512 * i, p = id >> 4, c16 = id & 15;
            *(LAS u32x4*)(lds + WT_OFF + p * WSs + c16 * 16) = *(const u32x4*)(wsb + (size_t)(g * 128 + p) * 128 + c16 * 8); }
        f32x4 ga0 = *(const f32x4*)(ln_g + g * 256 + cc * 8), ga1 = *(const f32x4*)(ln_g + g * 256 + cc * 8 + 4);
        f32x4 be0 = *(const f32x4*)(ln_b + g * 256 + cc * 8), be1 = *(const f32x4*)(ln_b + g * 256 + cc * 8 + 4);
#pragma unroll 2
        for (int i = 0; i < 8; ++i) { const int q = (tid >> 5) + 16 * i; const size_t row = (size_t)chunk * 128 + q;
            f32x2 st = stats[row * 32 + (lane & 31)];
#pragma unroll
            for (int o = 1; o < 32; o <<= 1) { st.x += __shfl_xor(st.x, o); st.y += __shfl_xor(st.y, o); }
            const float mean = st.x * (1.0f / EW), var = st.y * (1.0f / EW) - mean * mean, rstd = rsqrtf(fmaxf(var, 0.f) + EPS);
            const u32x4 vw = *(const u32x4*)(Z + row * 4096 + EW + g * 256 + cc * 8);
            f32x4 v0 = (f32x4){bf_lo(vw.x), bf_hi(vw.x), bf_lo(vw.y), bf_hi(vw.y)}, v1 = (f32x4){bf_lo(vw.z), bf_hi(vw.z), bf_lo(vw.w), bf_hi(vw.w)};
            v0 = (v0 - mean) * rstd * ga0 + be0; v1 = (v1 - mean) * rstd * ga1 + be1;
            u32x4 o; o.x = cvt_pk_bf16(v0[0], v0[1]); o.y = cvt_pk_bf16(v0[2], v0[3]); o.z = cvt_pk_bf16(v1[0], v1[1]); o.w = cvt_pk_bf16(v1[2], v1[3]);
            *(LAS u32x4*)(lds + VT_OFF + q * VS + cc * 16) = o; }
        __syncthreads();
        f32x4 d[2][8];
#pragma unroll
        for (int ct = 0; ct < 2; ++ct)
#pragma unroll
            for (int pt = 0; pt < 8; ++pt) d[ct][pt] = (f32x4){0.f, 0.f, 0.f, 0.f};
        const int c0 = 32 * w;
#pragma unroll
        for (int ks = 0; ks < 4; ++ks) {
            bf16x8 af[2];
#pragma unroll
            for (int ct = 0; ct < 2; ++ct) {
                const LAS unsigned char* p0 = lds + VT_OFF + (32 * ks + 8 * g4 + qq) * VS + (c0 + 16 * ct + 4 * pp) * 2;
                const s16x4 lo = __builtin_amdgcn_ds_read_tr16_b64_v4i16((LAS s16x4*)p0);
                const s16x4 hi = __builtin_amdgcn_ds_read_tr16_b64_v4i16((LAS s16x4*)(p0 + 4 * VS));
                af[ct] = __builtin_shufflevector(lo, hi, 0, 1, 2, 3, 4, 5, 6, 7);
            }
#pragma unroll
            for (int pt = 0; pt < 8; ++pt) {
                const bf16x8 bfr = *(const LAS bf16x8*)(lds + WT_OFF + (16 * pt + l15) * WSs + (32 * ks + 8 * g4) * 2);
#pragma unroll
                for (int ct = 0; ct < 2; ++ct) d[ct][pt] = __builtin_amdgcn_mfma_f32_16x16x32_bf16(af[ct], bfr, d[ct][pt], 0, 0, 0);
            }
        }
#pragma unroll
        for (int pt = 0; pt < 8; ++pt) {
            const int p = 16 * pt + l15; const float bs = b_s[g * 128 + p];
            bf16_t* rp = Z + ((size_t)chunk * 128 + p) * 4096 + g * 256 + c0 + 4 * g4;
#pragma unroll
            for (int ct = 0; ct < 2; ++ct) {
                const u32x2 uw = *(const u32x2*)(rp + 16 * ct);
                const f32x4 s = d[ct][pt] + bs;
                u32x2 o; o.x = cvt_pk_bf16(bf_lo(uw.x) * s[0], bf_hi(uw.x) * s[1]); o.y = cvt_pk_bf16(bf_lo(uw.y) * s[2], bf_hi(uw.y) * s[3]);
                *(u32x2*)(rp + 16 * ct) = o;
            }
        }
    }
}

__device__ __forceinline__ void attn_phase(LAS unsigned char* lds, const bf16_t* QKV, bf16_t* O, const float* sink, int G, int c) {
    constexpr int KS = 144, KBUF = 64 * KS, V_OFF = 2 * KBUF, NQB = 2;
    const int tid = threadIdx.x, lane = tid & 63, w = __builtin_amdgcn_readfirstlane(tid >> 6), l15 = lane & 15, g4 = lane >> 4, qq = l15 >> 2, pp = l15 & 3;
    const int which = tid >> 8, idx = tid & 255, lkey = idx >> 2, lcp = idx & 3;
    for (int u = c; u < BATCH * 64 * 4; u += G) {
        const int b = u >> 8, jh = (u >> 2) & 63, kvh = u & 3;
        const int hq = kvh * 4 + (w >> 1), qsub = (w & 1) * 32;
        const int q0 = jh * 64;
        const size_t rowbase = (size_t)b * SEQ + q0 + qsub;
        bf16x8 qf[NQB][2];
#pragma unroll
        for (int qb = 0; qb < NQB; ++qb)
#pragma unroll
            for (int ks = 0; ks < 2; ++ks) qf[qb][ks] = *(const bf16x8*)(QKV + (rowbase + qb * 16 + l15) * QKVD + hq * 64 + ks * 32 + g4 * 8);
        const float sk = sink[hq];
        float m_[NQB], l_[NQB]; f32x4 o[4][NQB];
#pragma unroll
        for (int qb = 0; qb < NQB; ++qb) { m_[qb] = sk; l_[qb] = (g4 == 0) ? 1.0f : 0.0f;
#pragma unroll
            for (int dt = 0; dt < 4; ++dt) o[dt][qb] = (f32x4){0.f, 0.f, 0.f, 0.f}; }
        const int tt_lo = (jh < 2) ? (2 - jh) : 0, tt_hi = (65 - jh < 4) ? (65 - jh) : 4, nlat = tt_hi - tt_lo + 1, ntiles = nlat + 4;
        const int lcol = (which ? 1280 : 1024) + kvh * 64 + lcp * 16;
#define TILE_ROW(i) ((i) < nlat ? ((size_t)b * SEQ + q0 - 128 + (tt_lo + (i)) * 64 + lkey) : ((size_t)MLAT + b * CTXL + ((i) - nlat) * 64 + lkey))
        u32x4 r0, r1;
        { const bf16_t* src = QKV + TILE_ROW(0) * QKVD + lcol; r0 = *(const u32x4*)src; r1 = *(const u32x4*)(src + 8);
          LAS unsigned char* dst = lds + which * V_OFF + lkey * KS + lcp * 32; *(LAS u32x4*)dst = r0; *(LAS u32x4*)(dst + 16) = r1; }
        __syncthreads();
        for (int it = 0; it < ntiles; ++it) {
            const bool more = (it + 1 < ntiles);
            if (more) { const bf16_t* src = QKV + TILE_ROW(it + 1) * QKVD + lcol; r0 = *(const u32x4*)src; r1 = *(const u32x4*)(src + 8); }
            const LAS unsigned char* Kb = lds + (it & 1) * KBUF; const LAS unsigned char* Vb = lds + V_OFF + (it & 1) * KBUF;
            f32x4 s[4][NQB];
#pragma unroll
            for (int kt = 0; kt < 4; ++kt) {
                const bf16x8 k0 = *(const LAS bf16x8*)(Kb + (kt * 16 + l15) * KS + g4 * 16), k1 = *(const LAS bf16x8*)(Kb + (kt * 16 + l15) * KS + 64 + g4 * 16);
#pragma unroll
                for (int qb = 0; qb < NQB; ++qb) {
                    f32x4 a = __builtin_amdgcn_mfma_f32_16x16x32_bf16(k0, qf[qb][0], (f32x4){0.f, 0.f, 0.f, 0.f}, 0, 0, 0);
                    s[kt][qb] = __builtin_amdgcn_mfma_f32_16x16x32_bf16(k1, qf[qb][1], a, 0, 0, 0);
                }
            }
            bf16x8 pf[NQB][2];
#pragma unroll
            for (int qb = 0; qb < NQB; ++qb) {
                float mx = -1e30f;
                if (it < nlat) {
                    const int qi = qsub + qb * 16 + l15, tt = tt_lo + it;
#pragma unroll
                    for (int kt = 0; kt < 4; ++kt)
#pragma unroll
                        for (int r = 0; r < 4; ++r) { const int dd = qi - tt * 64 - (kt * 16 + 4 * g4 + r); const bool ok = (dd <= 0) && (dd >= -256); s[kt][qb][r] = ok ? s[kt][qb][r] : -1e30f; }
                }
#pragma unroll
                for (int kt = 0; kt < 4; ++kt)
#pragma unroll
                    for (int r = 0; r < 4; ++r) mx = fmaxf(mx, s[kt][qb][r]);
                mx = fmaxf(mx, __shfl_xor(mx, 16)); mx = fmaxf(mx, __shfl_xor(mx, 32));
                const float mnew = fmaxf(m_[qb], mx), alpha = __builtin_amdgcn_exp2f((m_[qb] - mnew) * LOG2E);
                m_[qb] = mnew;
                float ps = 0.f;
#pragma unroll
                for (int kt = 0; kt < 4; ++kt)
#pragma unroll
                    for (int r = 0; r < 4; ++r) { const float p = __builtin_amdgcn_exp2f((s[kt][qb][r] - mnew) * LOG2E); ps += p; s[kt][qb][r] = p; }
                l_[qb] = l_[qb] * alpha + ps;
#pragma unroll
                for (int dt = 0; dt < 4; ++dt) o[dt][qb] *= alpha;
#pragma unroll
                for (int kk = 0; kk < 2; ++kk) {
                    u32x4 pw; pw.x = cvt_pk_bf16(s[2 * kk][qb][0], s[2 * kk][qb][1]); pw.y = cvt_pk_bf16(s[2 * kk][qb][2], s[2 * kk][qb][3]);
                    pw.z = cvt_pk_bf16(s[2 * kk + 1][qb][0], s[2 * kk + 1][qb][1]); pw.w = cvt_pk_bf16(s[2 * kk + 1][qb][2], s[2 * kk + 1][qb][3]);
                    pf[qb][kk] = __builtin_bit_cast(bf16x8, pw);
                }
            }
#pragma unroll
            for (int kk = 0; kk < 2; ++kk)
#pragma unroll
                for (int dt = 0; dt < 4; ++dt) {
                    const LAS unsigned char* p0 = Vb + (32 * kk + 4 * g4 + qq) * KS + (16 * dt + 4 * pp) * 2;
                    const s16x4 lo = __builtin_amdgcn_ds_read_tr16_b64_v4i16((LAS s16x4*)p0);
                    const s16x4 hi = __builtin_amdgcn_ds_read_tr16_b64_v4i16((LAS s16x4*)(p0 + 16 * KS));
                    const bf16x8 vf = __builtin_shufflevector(lo, hi, 0, 1, 2, 3, 4, 5, 6, 7);
#pragma unroll
                    for (int qb = 0; qb < NQB; ++qb) o[dt][qb] = __builtin_amdgcn_mfma_f32_16x16x32_bf16(vf, pf[qb][kk], o[dt][qb], 0, 0, 0);
                }
            if (more) { LAS unsigned char* dst = lds + which * V_OFF + ((it + 1) & 1) * KBUF + lkey * KS + lcp * 32; *(LAS u32x4*)dst = r0; *(LAS u32x4*)(dst + 16) = r1; }
            __syncthreads();
        }
#undef TILE_ROW
#pragma unroll
        for (int qb = 0; qb < NQB; ++qb) {
            float l = l_[qb]; l += __shfl_xor(l, 16); l += __shfl_xor(l, 32);
            const float inv = 1.0f / l;
            bf16_t* op = O + (rowbase + qb * 16 + l15) * D + hq * 64 + 4 * g4;
#pragma unroll
            for (int dt = 0; dt < 4; ++dt) { const f32x4 v = o[dt][qb] * inv; u32x2 wv; wv.x = cvt_pk_bf16(v[0], v[1]); wv.y = cvt_pk_bf16(v[2], v[3]); *(u32x2*)(op + 16 * dt) = wv; }
        }
    }
}

constexpr int N_PHASES = 18;
__global__ void __launch_bounds__(512, 2) mega_fwd(Args args) {
    extern __shared__ __attribute__((aligned(16))) unsigned char lds_raw[];
    LAS unsigned char* lds = (LAS unsigned char*)lds_raw;
    cg::grid_group grid = cg::this_grid();
    const int tid = threadIdx.x, lane = tid & 63, wave = __builtin_amdgcn_readfirstlane(tid >> 6);
    const int G = gridDim.x, bx = blockIdx.x;
    const int gw = bx * 8 + wave, NGW = G * 8, gtid = bx * 512 + tid, NT = G * 512;
    unsigned char* ws = args.ws;
    float* modv = (float*)(ws + WS_MODV); float* ropec = (float*)(ws + WS_ROPEC); float* ropes = (float*)(ws + WS_ROPES); float* biasp = (float*)(ws + WS_BIASP);
    bf16_t* wsb = (bf16_t*)(ws + WS_WS); f32x2* stats = (f32x2*)(ws + WS_STATS); float* ctxbuf = (float*)(ws + WS_CTX);
    bf16_t* win_t = (bf16_t*)(ws + WS_WIN); bf16_t* wout_t = (bf16_t*)(ws + WS_WOUT); bf16_t* wqkv_t = (bf16_t*)(ws + WS_WQKV); bf16_t* wo_t = (bf16_t*)(ws + WS_WO);
    bf16_t* wup_t = (bf16_t*)(ws + WS_WUP); bf16_t* wdn_t = (bf16_t*)(ws + WS_WDN);
    bf16_t* YH = (bf16_t*)(ws + WS_YH); bf16_t* BIG = (bf16_t*)(ws + WS_BIG); bf16_t* OBUF = (bf16_t*)(ws + WS_OBUF);
    const float* norm_g = args.in[I_NORMG];
    const int lo = args.ph_lo, hi = args.ph_hi;
#ifndef PHMASK
#define PHMASK 0x3ffff
#endif
#define IN(k) (((PHMASK >> (k)) & 1) && lo <= (k) && (k) < hi)
#define SEAM(k) do { if (IN(k) && IN((k) + 1)) { __syncthreads(); grid.sync(); } } while (0)

    if (IN(0)) {
        LAS float* sil = (LAS float*)(lds + 8 * 8448);
        for (int i = tid; i < 9 * 1024; i += 512) { const float v = (i < 8192) ? args.in[I_C][i] : args.in[I_CCTX][i - 8192]; sil[i] = v / (1.0f + __expf(-v)); }
        __syncthreads();
        LAS float* scr = (LAS float*)(lds + wave * 8448);
        constexpr int I_MOD = 192, I_WIN = 16 * 128, I_WOUT = 32 * 32, I_WQKV = 16 * 48, I_WO = 16 * 32, I_WUP = 16 * 176, I_WDN = 44 * 32;
        constexpr int NITEMS = I_MOD + I_WIN + I_WOUT + I_WQKV + I_WO + I_WUP + I_WDN;
        for (int it = gw; it < NITEMS; it += NGW) {
            int r = it;
            if (r < I_MOD) {
                const int layer = r / 96, col = (r % 96) * 64 + lane;
                const float* W = args.in[I_ADAW] + (size_t)layer * 1024 * 6144 + col;
                float acc[9];
#pragma unroll
                for (int b = 0; b < 9; ++b) acc[b] = 0.f;
                for (int k = 0; k < 1024; k += 4) {
                    const float w0 = W[(size_t)k * 6144], w1 = W[(size_t)(k + 1) * 6144], w2 = W[(size_t)(k + 2) * 6144], w3 = W[(size_t)(k + 3) * 6144];
#pragma unroll
                    for (int b = 0; b < 9; ++b) { const f32x4 sv = *(const LAS f32x4*)(sil + b * 1024 + k); acc[b] += sv[0] * w0 + sv[1] * w1 + sv[2] * w2 + sv[3] * w3; }
                }
                const float ab = args.in[I_ADAB][layer * 6144 + col];
#pragma unroll
                for (int b = 0; b < 9; ++b) modv[(size_t)(layer * 9 + b) * 6144 + col] = acc[b] + ab;
                continue;
            }
            r -= I_MOD;
            if (r < I_WIN) { transpose_item(args.in[I_AWIN], 1024, 4096, win_t, false, scr, r, lane); continue; } r -= I_WIN;
            if (r < I_WOUT) { transpose_item(args.in[I_AWOUT], 2048, 1024, wout_t, false, scr, r, lane); continue; } r -= I_WOUT;
            if (r < I_WQKV) { transpose_item(args.in[I_BWQKV], 1024, 1536, wqkv_t, true, scr, r, lane); continue; } r -= I_WQKV;
            if (r < I_WO) { transpose_item(args.in[I_BWO], 1024, 1024, wo_t, false, scr, r, lane); continue; } r -= I_WO;
            if (r < I_WUP) { transpose_item(args.in[I_FWUP], 1024, 5632, wup_t, false, scr, r, lane); continue; } r -= I_WUP;
            transpose_item(args.in[I_FWDN], 2816, 1024, wdn_t, false, scr, r, lane);
        }
        for (int i = gtid; i < 8 * 128 * 128 / 2; i += NT) { const f32x2 v = *(const f32x2*)(args.in[I_AWS] + 2 * i); ((unsigned*)wsb)[i] = cvt_pk_bf16(v.x, v.y); }
        for (int i = gtid; i < SEQ * 32; i += NT) {
            const int pos = i >> 5, f = i & 31; const float p = (f < 16) ? (float)(pos >> 6) : (float)(pos & 63);
            const float inv_freq = exp2f(-(float)(f & 15) * (13.287712379549449f / 16.0f));
            const float ang = p * inv_freq;
            double rev = (double)ang * 0.15915494309189535; rev -= floor(rev);
            ropec[i] = __builtin_amdgcn_cosf((float)rev); ropes[i] = __builtin_amdgcn_sinf((float)rev);
        }
        for (int i = gtid; i < QKVD; i += NT) biasp[qkv_dst_row(i)] = args.in[I_BBQKV][i];
    }
    SEAM(0);

    if (IN(1)) {
        RowArgs A{}; A.xin_lat = args.in[I_X]; A.xin_ctx = args.in[I_CTX]; A.Y = nullptr;
        A.ng_pre = norm_g + 0 * D; A.hmod = modv; A.sh_off = 0; A.sc_off = D; A.H = YH; A.nrows = MALL;
        row_phase(A, gw, NGW, lane);
    }
    SEAM(1);

    if (IN(2)) {
        pg8::Gemm g{YH, D, win_t, MALL, 4096, D}; pg8::StaticOrder S; S.init(MALL, 4096, G, bx);
        pg8::Epi<1> E{BIG, 4096, stats, nullptr, nullptr, nullptr};
        pg8::gemm_phase<pg8::Epi<1>, true, true>(lds, g, S, E);
    }
    SEAM(2);

    if (IN(3)) sgate_phase(lds, BIG, stats, wsb, args.in[I_ABS], args.in[I_ALNG], args.in[I_ALNB], G, bx);
    SEAM(3);

    if (IN(4)) {
        pg8::Gemm g{BIG, 4096, wout_t, MALL, D, EW}; pg8::StaticOrder S; S.init(MALL, D, G, bx);
        pg8::Epi<2> E{YH, D, stats, nullptr, nullptr, nullptr};
        pg8::gemm_phase<pg8::Epi<2>, true, true>(lds, g, S, E);
    }
    SEAM(4);

#define LAYER_TAIL(LI, PH, NROWS, XIN_LAT, XIN_CTX)                                                                               \
    if (IN(PH)) {                                                                                                                \
        RowArgs A{}; A.xin_lat = (XIN_LAT); A.xin_ctx = (XIN_CTX); A.xout_lat = args.out; A.xout_ctx = ctxbuf;                   \
        A.Y = YH; A.stats = stats; A.gmod = modv + (LI) * 9 * 6144; A.gate_off = 2 * D; A.ng_post = norm_g + ((LI) * 4 + 1) * D; \
        A.ng_pre = norm_g + ((LI) * 4 + 2) * D; A.hmod = modv + (LI) * 9 * 6144; A.sh_off = 3 * D; A.sc_off = 4 * D; A.H = YH; A.nrows = (NROWS); \
        row_phase(A, gw, NGW, lane);                                                                                             \
    }                                                                                                                            \
    SEAM(PH);                                                                                                                    \
    if (IN((PH) + 1)) {                                                                                                          \
        pg8::Gemm g{YH, D, wup_t, (NROWS), 2 * FF, D}; pg8::StaticOrder S; S.init((NROWS), 2 * FF, G, bx);                       \
        pg8::Epi<0> E{BIG, 2 * FF, nullptr, nullptr, nullptr, nullptr};                                                          \
        pg8::gemm_phase<pg8::Epi<0>, true, true>(lds, g, S, E);                                                                  \
    }                                                                                                                            \
    SEAM((PH) + 1);                                                                                                              \
    if (IN((PH) + 2)) conv_phase(BIG, args.in[I_FCONVW] + (LI) * 3 * FF, args.in[I_FCONVB] + (LI) * FF, (NROWS), gtid, NT);      \
    SEAM((PH) + 2);                                                                                                              \
    if (IN((PH) + 3)) {                                                                                                          \
        pg8::Gemm g{BIG + FF, 2 * FF, wdn_t, (NROWS), D, FF}; pg8::StaticOrder S; S.init((NROWS), D, G, bx);                     \
        pg8::Epi<2> E{YH, D, stats, nullptr, nullptr, nullptr};                                                                  \
        pg8::gemm_phase<pg8::Epi<2>, true, true>(lds, g, S, E);                                                                  \
    }                                                                                                                            \
    SEAM((PH) + 3);

    LAYER_TAIL(0, 5, MALL, args.in[I_X], args.in[I_CTX])

    if (IN(9)) {
        RowArgs A{}; A.xin_lat = args.out; A.xin_ctx = ctxbuf; A.xout_lat = args.out; A.xout_ctx = ctxbuf;
        A.Y = YH; A.stats = stats; A.gmod = modv; A.gate_off = 5 * D; A.ng_post = norm_g + 3 * D;
        A.ng_pre = norm_g + 4 * D; A.hmod = modv + 9 * 6144; A.sh_off = 0; A.sc_off = D; A.H = YH; A.nrows = MALL;
        row_phase(A, gw, NGW, lane);
        LAS float* scr = (LAS float*)(lds + wave * 8448);
        constexpr int I_WUP = 16 * 176, I_WDN = 44 * 32;
        for (int it = gw; it < I_WUP + I_WDN; it += NGW) {
            if (it < I_WUP) transpose_item(args.in[I_FWUP] + (size_t)D * 2 * FF, 1024, 5632, wup_t, false, scr, it, lane);
            else transpose_item(args.in[I_FWDN] + (size_t)FF * D, 2816, 1024, wdn_t, false, scr, it - I_WUP, lane);
        }
    }
    SEAM(9);

    if (IN(10)) {
        pg8::Gemm g{YH, D, wqkv_t, MALL, QKVD, D}; pg8::StaticOrder S; S.init(MALL, QKVD, G, bx);
        pg8::Epi<3> E{BIG, QKVD, nullptr, biasp, ropec, ropes};
        pg8::gemm_phase<pg8::Epi<3>, true, true>(lds, g, S, E);
    }
    SEAM(10);

    if (IN(11)) attn_phase(lds, BIG, OBUF, args.in[I_BSINK], G, bx);
    SEAM(11);

    if (IN(12)) {
        pg8::Gemm g{OBUF, D, wo_t, MLAT, D, D}; pg8::StaticOrder S; S.init(MLAT, D, G, bx);
        pg8::Epi<2> E{YH, D, stats, nullptr, nullptr, nullptr};
        pg8::gemm_phase<pg8::Epi<2>, true, true>(lds, g, S, E);
    }
    SEAM(12);

    LAYER_TAIL(1, 13, MLAT, args.out, ctxbuf)

    if (IN(17)) {
        RowArgs A{}; A.xin_lat = args.out; A.xin_ctx = ctxbuf; A.xout_lat = args.out; A.xout_ctx = ctxbuf;
        A.Y = YH; A.stats = stats; A.gmod = modv + 9 * 6144; A.gate_off = 5 * D; A.ng_post = norm_g + 7 * D;
        A.H = nullptr; A.nrows = MLAT;
        row_phase(A, gw, NGW, lane);
    }
#undef IN
#undef SEAM
}

extern "C" void kernel_launch(void* const* d_in, const int* in_sizes, int n_in, void* d_out, int out_size, void* d_ws, size_t ws_size, hipStream_t stream) {
    static int grid = 0;
    if (grid == 0) {
        if (n_in != 21 || ws_size < WS_END) { fprintf(stderr, "kernel_launch: expected 21 inputs and >= %zu bytes of workspace (got %d, %zu)\n", (size_t)WS_END, n_in, ws_size); grid = -1; return; }
        int dev = 0, cus = 0, per_cu = 0;
        hipGetDevice(&dev); hipDeviceGetAttribute(&cus, hipDeviceAttributeMultiprocessorCount, dev);
        if (hipFuncSetAttribute((const void*)mega_fwd, hipFuncAttributeMaxDynamicSharedMemorySize, LDS_BYTES) != hipSuccess) { fprintf(stderr, "kernel_launch: hipFuncSetAttribute failed\n"); grid = -1; return; }
        if (hipOccupancyMaxActiveBlocksPerMultiprocessor(&per_cu, (const void*)mega_fwd, 512, LDS_BYTES) != hipSuccess || per_cu < 1) { fprintf(stderr, "kernel_launch: occupancy query says %d\n", per_cu); per_cu = 1; }
        (void)hipGetLastError();
        grid = cus * 1;
    }
    if (grid < 0) return;
    Args a{};
    for (int i = 0; i < 21; ++i) a.in[i] = (const float*)d_in[i];
    a.out = (float*)d_out; a.ws = (unsigned char*)d_ws;
#if MK_PER_PHASE_LAUNCH
    for (int p = 0; p < N_PHASES; ++p) { a.ph_lo = p; a.ph_hi = p + 1; hipLaunchKernelGGL(mega_fwd, dim3(grid), dim3(512), LDS_BYTES, stream, a); }
#else
    a.ph_lo = 0; a.ph_hi = N_PHASES;
    void* kargs[] = {&a};
    hipError_t e = hipLaunchCooperativeKernel((const void*)mega_fwd, dim3(grid), dim3(512), kargs, LDS_BYTES, stream);
    if (e != hipSuccess) fprintf(stderr, "cooperative launch failed: %s (grid %d)\n", hipGetErrorString(e), grid);
#endif
}
```

```cpp
#include <hip/hip_runtime.h>
#include <hip/hip_cooperative_groups.h>
#include <cstdio>
#include <cstdint>
namespace cg = cooperative_groups;

#ifndef MK_PER_PHASE_LAUNCH
#define MK_PER_PHASE_LAUNCH 0
#endif

#define LAS __attribute__((address_space(3)))
typedef unsigned short bf16_t;
typedef short bf16x8 __attribute__((ext_vector_type(8)));
typedef short s16x4 __attribute__((ext_vector_type(4)));
typedef float f32x4 __attribute__((ext_vector_type(4)));
typedef float f32x2 __attribute__((ext_vector_type(2)));
typedef unsigned u32x4 __attribute__((ext_vector_type(4)));
typedef unsigned u32x2 __attribute__((ext_vector_type(2)));

constexpr int D = 1024, BATCH = 8, SEQ = 4096, CTXL = 256;
constexpr int MLAT = BATCH * SEQ, MCTX = BATCH * CTXL, MALL = MLAT + MCTX;
constexpr int EW = 2048, FF = 2816, QKVD = 1536;
constexpr float EPS = 1e-6f;
constexpr float LOG2E = 1.4426950408889634f;

constexpr size_t MiB = 1u << 20;
constexpr size_t WS_MODV = 0;
constexpr size_t WS_ROPEC = 1 * MiB;
constexpr size_t WS_ROPES = WS_ROPEC + 512 * 1024;
constexpr size_t WS_BIASP = 2 * MiB;
constexpr size_t WS_WS = 2 * MiB + 64 * 1024;
constexpr size_t WS_BAR = 2 * MiB + 512 * 1024;
constexpr size_t WS_STATS = 3 * MiB;
constexpr size_t WS_CTX = 12 * MiB;
constexpr size_t WS_WIN = 20 * MiB;
constexpr size_t WS_WOUT = 28 * MiB;
constexpr size_t WS_WQKV = 32 * MiB;
constexpr size_t WS_WO = 35 * MiB;
constexpr size_t WS_WUP = 37 * MiB;
constexpr size_t WS_WDN = 48 * MiB;
constexpr size_t WS_YH = 54 * MiB;
constexpr size_t WS_BIG = 122 * MiB;
constexpr size_t WS_OBUF = WS_BIG + 104 * MiB;
constexpr size_t WS_END = WS_BIG + (size_t)MALL * 5632 * 2;
static_assert(WS_END <= 512 * MiB, "ws map");

constexpr int LDS_BYTES = 147456;

__device__ __forceinline__ unsigned cvt_pk_bf16(float lo, float hi) { unsigned r; asm("v_cvt_pk_bf16_f32 %0, %1, %2" : "=v"(r) : "v"(lo), "v"(hi)); return r; }
__device__ __forceinline__ float bf_lo(unsigned w) { return __uint_as_float(w << 16); }
__device__ __forceinline__ float bf_hi(unsigned w) { return __uint_as_float(w & 0xffff0000u); }
__device__ __forceinline__ float wave_sum(float v) {
#pragma unroll
    for (int o = 1; o < 64; o <<= 1) v += __shfl_xor(v, o);
    return v;
}
__device__ __forceinline__ float gelu_t(float x) {
    const float u = x * (0.7978845608f + 0.0356774081f * x * x);
    const float e = __builtin_amdgcn_exp2f(-2.885390082f * u);
    return x * __builtin_amdgcn_rcpf(1.0f + e);
}
__device__ __forceinline__ int qkv_dst_row(int c) {
    if (c >= 1280) return c;
    const int head = c >> 6, d = c & 63;
    const int p = (d < 32) ? (8 * (d >> 2) + (d & 3)) : (8 * ((d - 32) >> 2) + 4 + (d & 3));
    return head * 64 + p;
}

namespace pg8 {
constexpr int BM = 256, BK = 64, HALF = 128, HTB = HALF * BK * 2, STAGE_BYTES = 8 * HTB, NXCD = 8, WGM = 8;
__host__ __device__ __forceinline__ int lds_byte(int r, int c) { const int st = (r >> 4) * 2 + (c >> 5), rr = r & 15, cc = c & 31, ob = rr * 64 + cc * 2; return st * 1024 + (ob ^ (((ob >> 9) & 1) << 5)); }
__host__ __device__ __forceinline__ void stage_rc(int b, int& R, int& C) { const int st = b / 1024, sb = b % 1024, swz = sb ^ (((sb >> 9) & 1) << 5); R = (st >> 1) * 16 + swz / 64; C = (st & 1) * 32 + (swz % 64) / 2; }
__host__ __device__ __forceinline__ int perm32(int rho) { const int n = rho >> 4, i = rho & 15; return 8 * (i >> 2) + 4 * n + (i & 3); }

struct Unit { int pm, pn; };
struct Gemm { const bf16_t* A; int lda; const bf16_t* Bt; int M, N, K; };

struct StaticOrder {
    int nM, nN, nwg, G, c;
    __host__ __device__ void init(int M, int N, int G_, int c_) { nM = M / BM; nN = N / BM; nwg = nM * nN; G = G_; c = c_; }
    __host__ __device__ bool next(int i, Unit& u) const {
        const long L = (long)i * G + c; if (L >= nwg) return false;
        int wgid = (int)L; { const int q = nwg / NXCD, r = nwg % NXCD, xcd = wgid % NXCD, off = wgid / NXCD; wgid = (xcd < r ? xcd * (q + 1) : r * (q + 1) + (xcd - r) * q) + off; }
        const int nig = WGM * nN, gid = wgid / nig, fm = gid * WGM, gsz = (nM - fm) < WGM ? (nM - fm) : WGM;
        u.pm = fm + ((wgid % nig) % gsz); u.pn = (wgid % nig) / gsz; return true;
    }
};

template <int MODE> struct Epi {
    static constexpr bool PERM = true;
    bf16_t* O; int ldc; f32x2* stats; const float* bias; const float* ropec; const float* ropes;
    __device__ __forceinline__ void operator()(const f32x4 (&acc)[2][2][4][2], const Unit& u, int wr, int wc, int fr, int fq) const {
        const int row0 = u.pm * BM + wr * 64 + fr, colt = u.pn * BM + wc * 32 + 8 * fq;
        f32x4 bv[2][2];
        if (MODE == 3) {
#pragma unroll
            for (int bj = 0; bj < 2; ++bj)
#pragma unroll
                for (int n = 0; n < 2; ++n) bv[bj][n] = *(const f32x4*)(bias + colt + bj * HALF + 4 * n);
        }
        const bool do_stats = (MODE == 2) || (MODE == 1 && u.pn >= 8);
        const int sidx = (MODE == 1 ? (u.pn - 8) : u.pn) * 4 + wc;
#pragma unroll
        for (int ai = 0; ai < 2; ++ai)
#pragma unroll
            for (int m = 0; m < 4; ++m) {
                const int row = row0 + ai * HALF + m * 16;
                bf16_t* rowp = O + (size_t)row * ldc + colt;
                float s = 0.f, q = 0.f;
                f32x4 rc, rs;
                const bool do_rope = (MODE == 3) && (u.pn < 5) && (row < MLAT);
                if (MODE == 3) {
                    if (do_rope) { const int pos = row & (SEQ - 1), mm = (wc & 1) * 4 + fq; rc = *(const f32x4*)(ropec + pos * 32 + 4 * mm); rs = *(const f32x4*)(ropes + pos * 32 + 4 * mm); }
                    else { rc = (f32x4){1.f, 1.f, 1.f, 1.f}; rs = (f32x4){0.f, 0.f, 0.f, 0.f}; }
                }
#pragma unroll
                for (int bj = 0; bj < 2; ++bj) {
                    f32x4 v0 = acc[ai][bj][m][0], v1 = acc[ai][bj][m][1];
                    if (MODE == 1) {
#pragma unroll
                        for (int j = 0; j < 4; ++j) { v0[j] = gelu_t(v0[j]); v1[j] = gelu_t(v1[j]); }
                    }
                    if (MODE == 3) {
                        v0 += bv[bj][0]; v1 += bv[bj][1];
                        const f32x4 x1 = v0, x2 = v1;
                        v0 = x1 * rc - x2 * rs; v1 = x2 * rc + x1 * rs;
                        if (u.pn < 4) { v0 *= 0.125f; v1 *= 0.125f; }
                    }
                    if (MODE == 1 || MODE == 2) {
#pragma unroll
                        for (int j = 0; j < 4; ++j) { s += v0[j] + v1[j]; q += v0[j] * v0[j] + v1[j] * v1[j]; }
                    }
                    u32x4 w; w.x = cvt_pk_bf16(v0[0], v0[1]); w.y = cvt_pk_bf16(v0[2], v0[3]); w.z = cvt_pk_bf16(v1[0], v1[1]); w.w = cvt_pk_bf16(v1[2], v1[3]);
                    *(u32x4*)(rowp + bj * HALF) = w;
                }
                if (MODE == 1 || MODE == 2) {
                    s += __shfl_xor(s, 16); s += __shfl_xor(s, 32); q += __shfl_xor(q, 16); q += __shfl_xor(q, 32);
                    if (do_stats && fq == 0) stats[(size_t)row * 32 + sidx] = (f32x2){s, q};
                }
            }
    }
};

template <class EpiT, bool ALIGN_EPI, bool SP2>
__device__ __forceinline__ void gemm_phase(LAS unsigned char* lds, const Gemm g, const StaticOrder& S, const EpiT& E) {
    const int tid = threadIdx.x, wid = __builtin_amdgcn_readfirstlane(tid >> 6), lane = tid & 63, wr = wid >> 2, wc = wid & 3, fr = lane & 15, fq = lane >> 4;
    const int K = g.K, nt = K / BK, lda = g.lda;
    unsigned voffA[2], voffB[2];
#pragma unroll
    for (int i = 0; i < 2; ++i) { int R, C; stage_rc(tid * 16 + i * 8192, R, C); const int Rb = EpiT::PERM ? ((R & ~31) + perm32(R & 31)) : R;
        voffA[i] = (unsigned)(R * lda + C) * 2u; voffB[i] = (unsigned)(Rb * K + C) * 2u; }
    const size_t kstep = (size_t)(BK * 2);
    const size_t hA = (size_t)HALF * lda * 2, hB = (size_t)HALF * K * 2;
    const size_t tA = 2 * hA, tB = 2 * hB;
    const unsigned ldsw = (unsigned)wid * 1024u;
    const int aoff = lds_byte(wr * 64 + fr, fq * 8), boff = lds_byte(wc * 32 + fr, fq * 8);
#define PG8_SA(b, h) (((b) * 2 + (h)) * HTB)
#define PG8_SB(b, h) ((4 + (b) * 2 + (h)) * HTB)
#define PG8_STAGE(bufoff, gbase, voff) do { _Pragma("unroll") for (int _i = 0; _i < 2; ++_i) \
        __builtin_amdgcn_global_load_lds((const unsigned*)((const char*)(gbase) + (voff)[_i]), (LAS unsigned*)(lds + (bufoff) + ldsw + _i * 8192), 16, 0, 0); } while (0)
#define PG8_LDA(dst, b, h) do { _Pragma("unroll") for (int m = 0; m < 4; ++m) _Pragma("unroll") for (int k = 0; k < 2; ++k) dst[m][k] = *(const LAS bf16x8*)(lds + PG8_SA(b, h) + aoff + m * 2048 + k * 1024); } while (0)
#define PG8_LDB(dst, b, h) do { _Pragma("unroll") for (int n = 0; n < 2; ++n) _Pragma("unroll") for (int k = 0; k < 2; ++k) dst[n][k] = *(const LAS bf16x8*)(lds + PG8_SB(b, h) + boff + n * 2048 + k * 1024); } while (0)
#define PG8_MMA(ai, bj, At, Bt) do { __builtin_amdgcn_s_setprio(1); _Pragma("unroll") for (int m = 0; m < 4; ++m) _Pragma("unroll") for (int n = 0; n < 2; ++n) _Pragma("unroll") for (int k = 0; k < 2; ++k) \
        acc[ai][bj][m][n] = __builtin_amdgcn_mfma_f32_16x16x32_bf16(Bt[n][k], At[m][k], acc[ai][bj][m][n], 0, 0, 0); __builtin_amdgcn_s_setprio(0); } while (0)
#define PG8_WAIT_V(n) asm volatile("s_waitcnt vmcnt(" #n ")" ::: "memory")
#define PG8_WAIT_L(n) asm volatile("s_waitcnt lgkmcnt(" #n ")" ::: "memory")
#define PG8_BAR __builtin_amdgcn_s_barrier()
#define PG8_SCHED __builtin_amdgcn_sched_barrier(0)
    Unit cur, nxt; int ui = 0;
    if (!S.next(0, cur)) return;
    f32x4 acc[2][2][4][2];
#pragma unroll
    for (int a = 0; a < 2; ++a)
#pragma unroll
        for (int b = 0; b < 2; ++b)
#pragma unroll
            for (int m = 0; m < 4; ++m)
#pragma unroll
                for (int n = 0; n < 2; ++n) acc[a][b][m][n] = (f32x4){0.f, 0.f, 0.f, 0.f};
    bf16x8 At[4][2], B0[2][2], B1[2][2];
    const char* cA = (const char*)g.A + (size_t)cur.pm * tA; const char* cB = (const char*)g.Bt + (size_t)cur.pn * tB;
    if constexpr (SP2) {
        PG8_STAGE(PG8_SB(0, 0), cB, voffB); PG8_STAGE(PG8_SB(0, 1), cB + hB, voffB); PG8_STAGE(PG8_SA(0, 0), cA, voffA); PG8_STAGE(PG8_SA(0, 1), cA + hA, voffA);
        if (wr == 1) PG8_BAR;
        PG8_WAIT_V(2); PG8_BAR;
        PG8_STAGE(PG8_SB(1, 0), cB + kstep, voffB); PG8_STAGE(PG8_SA(1, 0), cA + kstep, voffA); PG8_STAGE(PG8_SB(1, 1), cB + hB + kstep, voffB);
        PG8_WAIT_V(6); PG8_BAR;
    } else {
        PG8_STAGE(PG8_SB(0, 0), cB, voffB); PG8_STAGE(PG8_SA(0, 0), cA, voffA); PG8_STAGE(PG8_SB(0, 1), cB + hB, voffB); PG8_STAGE(PG8_SA(0, 1), cA + hA, voffA);
        if (wr == 1) PG8_BAR;
        PG8_WAIT_V(4); PG8_BAR;
        PG8_STAGE(PG8_SB(1, 0), cB + kstep, voffB); PG8_STAGE(PG8_SA(1, 0), cA + kstep, voffA); PG8_STAGE(PG8_SB(1, 1), cB + hB + kstep, voffB);
        PG8_WAIT_V(6); PG8_BAR;
    }
    for (;;) {
        const bool has_next = S.next(ui + 1, nxt);
        const char* nA = has_next ? (const char*)g.A + (size_t)nxt.pm * tA : cA; const char* nB = has_next ? (const char*)g.Bt + (size_t)nxt.pn * tB : cB;
        for (int t = 0; t < nt; t += 2) {
            const bool last = (t == nt - 2);
            const char* a1 = cA + (size_t)(t + 1) * kstep;
            const char* a2 = last ? nA : cA + (size_t)(t + 2) * kstep; const char* b2 = last ? nB : cB + (size_t)(t + 2) * kstep;
            const char* a3 = a2 + kstep; const char* b3 = b2 + kstep;
            if constexpr (SP2) {
            PG8_LDB(B0, 0, 0); PG8_LDB(B1, 0, 1); PG8_SCHED; PG8_LDA(At, 0, 0); PG8_STAGE(PG8_SA(1, 1), a1 + hA, voffA);
            PG8_WAIT_V(8); PG8_WAIT_L(0); PG8_BAR; PG8_MMA(0, 0, At, B0); PG8_MMA(0, 1, At, B1); PG8_BAR; PG8_SCHED;
            PG8_LDA(At, 0, 1); PG8_STAGE(PG8_SB(0, 0), b2, voffB); PG8_STAGE(PG8_SB(0, 1), b2 + hB, voffB); PG8_STAGE(PG8_SA(0, 0), a2, voffA);
            PG8_WAIT_V(8); PG8_WAIT_L(0); PG8_BAR; PG8_MMA(1, 0, At, B0); PG8_MMA(1, 1, At, B1); PG8_BAR; PG8_SCHED;
            PG8_LDB(B0, 1, 0); PG8_LDB(B1, 1, 1); PG8_SCHED; PG8_LDA(At, 1, 0); PG8_STAGE(PG8_SA(0, 1), a2 + hA, voffA);
            PG8_WAIT_V(8); PG8_WAIT_L(0); PG8_BAR; PG8_MMA(0, 0, At, B0); PG8_MMA(0, 1, At, B1); PG8_BAR; PG8_SCHED;
            PG8_LDA(At, 1, 1); PG8_STAGE(PG8_SB(1, 0), b3, voffB); PG8_STAGE(PG8_SB(1, 1), b3 + hB, voffB); PG8_STAGE(PG8_SA(1, 0), a3, voffA);
            PG8_WAIT_V(8); PG8_WAIT_L(0); PG8_BAR; PG8_MMA(1, 0, At, B0); PG8_MMA(1, 1, At, B1); PG8_BAR; PG8_SCHED;
            } else {
            PG8_LDB(B0, 0, 0); PG8_SCHED; PG8_LDA(At, 0, 0); PG8_STAGE(PG8_SA(1, 1), a1 + hA, voffA);
            PG8_WAIT_L(8); PG8_BAR; PG8_WAIT_L(0); PG8_MMA(0, 0, At, B0); PG8_BAR; PG8_SCHED;
            PG8_LDB(B1, 0, 1); PG8_STAGE(PG8_SB(0, 0), b2, voffB);
            PG8_BAR; PG8_WAIT_L(0); PG8_MMA(0, 1, At, B1); PG8_BAR;
            PG8_LDA(At, 0, 1); PG8_STAGE(PG8_SA(0, 0), a2, voffA);
            PG8_BAR; PG8_WAIT_L(0); PG8_MMA(1, 0, At, B0); PG8_BAR; PG8_SCHED;
            PG8_STAGE(PG8_SB(0, 1), b2 + hB, voffB);
            PG8_WAIT_V(6); PG8_BAR; PG8_MMA(1, 1, At, B1); PG8_BAR;
            PG8_LDB(B0, 1, 0); PG8_SCHED; PG8_LDA(At, 1, 0); PG8_STAGE(PG8_SA(0, 1), a2 + hA, voffA);
            PG8_WAIT_L(8); PG8_BAR; PG8_WAIT_L(0); PG8_MMA(0, 0, At, B0); PG8_BAR; PG8_SCHED;
            PG8_LDB(B1, 1, 1); PG8_STAGE(PG8_SB(1, 0), b3, voffB);
            PG8_BAR; PG8_WAIT_L(0); PG8_MMA(0, 1, At, B1); PG8_BAR;
            PG8_LDA(At, 1, 1); PG8_STAGE(PG8_SA(1, 0), a3, voffA);
            PG8_BAR; PG8_WAIT_L(0); PG8_MMA(1, 0, At, B0); PG8_BAR; PG8_SCHED;
            PG8_STAGE(PG8_SB(1, 1), b3 + hB, voffB);
            PG8_WAIT_V(6); PG8_BAR; PG8_MMA(1, 1, At, B1); PG8_BAR;
            }
        }
        if constexpr (ALIGN_EPI) { if (wr == 0) PG8_BAR; }
        E(acc, cur, wr, wc, fr, fq);
        if (!has_next) break;
#pragma unroll
        for (int a = 0; a < 2; ++a)
#pragma unroll
            for (int b = 0; b < 2; ++b)
#pragma unroll
                for (int m = 0; m < 4; ++m)
#pragma unroll
                    for (int n = 0; n < 2; ++n) acc[a][b][m][n] = (f32x4){0.f, 0.f, 0.f, 0.f};
        cur = nxt; cA = nA; cB = nB; ++ui;
        if constexpr (ALIGN_EPI) { if (wr == 1) PG8_BAR; }
    }
    PG8_WAIT_V(0);
    if constexpr (!ALIGN_EPI) { if (wr == 0) PG8_BAR; }
    PG8_BAR;
#undef PG8_SA
#undef PG8_SB
#undef PG8_STAGE
#undef PG8_LDA
#undef PG8_LDB
#undef PG8_MMA
#undef PG8_WAIT_V
#undef PG8_WAIT_L
#undef PG8_BAR
#undef PG8_SCHED
}
}

struct Args { const float* in[21]; float* out; unsigned char* ws; int ph_lo, ph_hi; };
enum { I_X = 0, I_C, I_CTX, I_CCTX, I_ADAW, I_ADAB, I_NORMG, I_AWIN, I_ALNG, I_ALNB, I_AWS, I_ABS, I_AWOUT, I_BWQKV, I_BBQKV, I_BSINK, I_BWO, I_FWUP, I_FCONVW, I_FCONVB, I_FWDN };

__device__ __forceinline__ void transpose_item(const float* W, int K, int N, bf16_t* WT, bool perm, LAS float* scr, int item, int lane) {
    const int nblk = N / 32, kb = item / nblk, nb = item % nblk, k0 = 64 * kb, n0 = 32 * nb;
#pragma unroll 8
    for (int i = 0; i < 32; ++i) { const int kk = 2 * i + (lane >> 5); scr[kk * 33 + (lane & 31)] = W[(size_t)(k0 + kk) * N + n0 + (lane & 31)]; }
    asm volatile("s_waitcnt lgkmcnt(0)" ::: "memory");
    const int c = lane & 7;
#pragma unroll
    for (int j = 0; j < 4; ++j) { const int n = (lane >> 3) + 8 * j; const LAS float* s = scr + (8 * c) * 33 + n;
        u32x4 o; o.x = cvt_pk_bf16(s[0 * 33], s[1 * 33]); o.y = cvt_pk_bf16(s[2 * 33], s[3 * 33]); o.z = cvt_pk_bf16(s[4 * 33], s[5 * 33]); o.w = cvt_pk_bf16(s[6 * 33], s[7 * 33]);
        const int dr = perm ? qkv_dst_row(n0 + n) : (n0 + n);
        *(u32x4*)(WT + (size_t)dr * K + k0 + 8 * c) = o; }
    asm volatile("s_waitcnt lgkmcnt(0)" ::: "memory");
}

struct RowArgs {
    const float* xin_lat; const float* xin_ctx; float* xout_lat; float* xout_ctx;
    const bf16_t* Y; const f32x2* stats; const float* gmod; int gate_off; const float* ng_post;
    const float* ng_pre; const float* hmod; int sh_off, sc_off; bf16_t* H; int nrows;
};
__device__ __forceinline__ void row_phase(const RowArgs& A, int gw, int NGW, int lane) {
    for (int row = gw; row < A.nrows; row += NGW) {
        const bool lat = row < MLAT; const int bidx = lat ? (row >> 12) : 8;
        const float* xi = lat ? A.xin_lat + (size_t)row * D : A.xin_ctx + (size_t)(row - MLAT) * D;
        f32x4 x[4];
#pragma unroll
        for (int j = 0; j < 4; ++j) x[j] = *(const f32x4*)(xi + 4 * lane + 256 * j);
        if (A.Y) {
            float ss = (lane < 16) ? A.stats[(size_t)row * 32 + lane].y : 0.f; ss = wave_sum(ss);
            const float rstd = rsqrtf(ss * (1.0f / D) + EPS);
            const float* gate = A.gmod + bidx * 6144 + A.gate_off;
#pragma unroll
            for (int j = 0; j < 4; ++j) { const int col = 4 * lane + 256 * j;
                const u32x2 yw = *(const u32x2*)(A.Y + (size_t)row * D + col);
                const f32x4 y = (f32x4){bf_lo(yw.x), bf_hi(yw.x), bf_lo(yw.y), bf_hi(yw.y)};
                const f32x4 g4 = *(const f32x4*)(gate + col), n4 = *(const f32x4*)(A.ng_post + col);
                x[j] += g4 * (y * rstd * n4); }
            float* xo = lat ? A.xout_lat + (size_t)row * D : A.xout_ctx + (size_t)(row - MLAT) * D;
#pragma unroll
            for (int j = 0; j < 4; ++j) *(f32x4*)(xo + 4 * lane + 256 * j) = x[j];
        }
        if (A.H) {
            float s2 = 0.f;
#pragma unroll
            for (int j = 0; j < 4; ++j) s2 += (x[j][0] * x[j][0] + x[j][1] * x[j][1]) + (x[j][2] * x[j][2] + x[j][3] * x[j][3]);
            s2 = wave_sum(s2);
            const float rstd2 = rsqrtf(s2 * (1.0f / D) + EPS);
            const float* sh = A.hmod + bidx * 6144 + A.sh_off; const float* sc = A.hmod + bidx * 6144 + A.sc_off;
#pragma unroll
            for (int j = 0; j < 4; ++j) { const int col = 4 * lane + 256 * j;
                const f32x4 n4 = *(const f32x4*)(A.ng_pre + col), s4 = *(const f32x4*)(sh + col), c4 = *(const f32x4*)(sc + col);
                const f32x4 h = (x[j] * rstd2 * n4) * (c4 + 1.0f) + s4;
                u32x2 w; w.x = cvt_pk_bf16(h[0], h[1]); w.y = cvt_pk_bf16(h[2], h[3]);
                *(u32x2*)(A.H + (size_t)row * D + col) = w; }
        }
    }
}

__device__ __forceinline__ void conv_phase(bf16_t* AB, const float* cw, const float* cb, int nrows, int gtid, int nthreads) {
    constexpr int RUN = 16, NCH = FF / 8;
    const int total = (nrows / RUN) * NCH;
    for (int it = gtid; it < total; it += nthreads) {
        const int ch = it % NCH, run = it / NCH, r0 = run * RUN, c0 = ch * 8;
        const bool lat = r0 < MLAT; const int pos0 = lat ? (r0 & (SEQ - 1)) : ((r0 - MLAT) & (CTXL - 1)); const int L = lat ? SEQ : CTXL;
        float w0[8], w1[8], w2[8], bb[8];
#pragma unroll
        for (int h = 0; h < 2; ++h) { const f32x4 a = *(const f32x4*)(cw + c0 + 4 * h), b = *(const f32x4*)(cw + FF + c0 + 4 * h), c = *(const f32x4*)(cw + 2 * FF + c0 + 4 * h), d = *(const f32x4*)(cb + c0 + 4 * h);
#pragma unroll
            for (int j = 0; j < 4; ++j) { w0[4 * h + j] = a[j]; w1[4 * h + j] = b[j]; w2[4 * h + j] = c[j]; bb[4 * h + j] = d[j]; } }
        bf16_t* base = AB + (size_t)r0 * (2 * FF) + c0;
        u32x4 ap = (u32x4){0u, 0u, 0u, 0u}, ac, an;
        if (pos0 > 0) ap = *(const u32x4*)(base - 2 * FF);
        ac = *(const u32x4*)(base);
#pragma unroll 4
        for (int r = 0; r < RUN; ++r) {
            bf16_t* rp = base + (size_t)r * (2 * FF);
            an = (u32x4){0u, 0u, 0u, 0u};
            if (pos0 + r + 1 < L) an = *(const u32x4*)(rp + 2 * FF);
            const u32x4 bw = *(const u32x4*)(rp + FF);
            u32x4 o;
#pragma unroll
            for (int k = 0; k < 4; ++k) {
                const float c_lo = bf_lo(ap[k]) * w0[2 * k] + bf_lo(ac[k]) * w1[2 * k] + bf_lo(an[k]) * w2[2 * k] + bb[2 * k];
                const float c_hi = bf_hi(ap[k]) * w0[2 * k + 1] + bf_hi(ac[k]) * w1[2 * k + 1] + bf_hi(an[k]) * w2[2 * k + 1] + bb[2 * k + 1];
                o[k] = cvt_pk_bf16(gelu_t(c_lo) * bf_lo(bw[k]), gelu_t(c_hi) * bf_hi(bw[k]));
            }
            *(u32x4*)(rp + FF) = o;
            ap = ac; ac = an;
        }
    }
}

__device__ __forceinline__ void sgate_phase(LAS unsigned char* lds, bf16_t* Z, const f32x2* stats, const bf16_t* wsb, const float* b_s, const float* ln_g, const float* ln_b, int G, int c) {
    constexpr int VS = 528, WSs = 272, VT_OFF = 0, WT_OFF = 128 * VS;
    const int tid = threadIdx.x, lane = tid & 63, w = __builtin_amdgcn_readfirstlane(tid >> 6), l15 = lane & 15, g4 = lane >> 4, qq = l15 >> 2, pp = l15 & 3;
    const int cc = tid & 31;
    for (int item = c; item < (MALL / 128) * 8; item += G) {
        const int chunk = item >> 3, g = item & 7;
        __syncthreads();
#pragma unroll
        for (int i = 0; i < 4; ++i) { const int id = tid + 512 * i, p = id >> 4, c16 = id & 15;
            *(LAS u32x4*)(lds + WT_OFF + p * WSs + c16 * 16) = *(const u32x4*)(wsb + (size_t)(g * 128 + p) * 128 + c16 * 8); }
        f32x4 ga0 = *(const f32x4*)(ln_g + g * 256 + cc * 8), ga1 = *(const f32x4*)(ln_g + g * 256 + cc * 8 + 4);
        f32x4 be0 = *(const f32x4*)(ln_b + g * 256 + cc * 8), be1 = *(const f32x4*)(ln_b + g * 256 + cc * 8 + 4);
#pragma unroll 2
        for (int i = 0; i < 8; ++i) { const int q = (tid >> 5) + 16 * i; const size_t row = (size_t)chunk * 128 + q;
            f32x2 st = stats[row * 32 + (lane & 31)];
#pragma unroll
            for (int o = 1; o < 32; o <<= 1) { st.x += __shfl_xor(st.x, o); st.y += __shfl_xor(st.y, o); }
            const float mean = st.x * (1.0f / EW), var = st.y * (1.0f / EW) - mean * mean, rstd = rsqrtf(fmaxf(var, 0.f) + EPS);
            const u32x4 vw = *(const u32x4*)(Z + row * 4096 + EW + g * 256 + cc * 8);
            f32x4 v0 = (f32x4){bf_lo(vw.x), bf_hi(vw.x), bf_lo(vw.y), bf_hi(vw.y)}, v1 = (f32x4){bf_lo(vw.z), bf_hi(vw.z), bf_lo(vw.w), bf_hi(vw.w)};
            v0 = (v0 - mean) * rstd * ga0 + be0; v1 = (v1 - mean) * rstd * ga1 + be1;
            u32x4 o; o.x = cvt_pk_bf16(v0[0], v0[1]); o.y = cvt_pk_bf16(v0[2], v0[3]); o.z = cvt_pk_bf16(v1[0], v1[1]); o.w = cvt_pk_bf16(v1[2], v1[3]);
            *(LAS u32x4*)(lds + VT_OFF + q * VS + cc * 16) = o; }
        __syncthreads();
        f32x4 d[2][8];
#pragma unroll
        for (int ct = 0; ct < 2; ++ct)
#pragma unroll
            for (int pt = 0; pt < 8; ++pt) d[ct][pt] = (f32x4){0.f, 0.f, 0.f, 0.f};
        const int c0 = 32 * w;
#pragma unroll
        for (int ks = 0; ks < 4; ++ks) {
            bf16x8 af[2];
#pragma unroll
            for (int ct = 0; ct < 2; ++ct) {
                const LAS unsigned char* p0 = lds + VT_OFF + (32 * ks + 8 * g4 + qq) * VS + (c0 + 16 * ct + 4 * pp) * 2;
                const s16x4 lo = __builtin_amdgcn_ds_read_tr16_b64_v4i16((LAS s16x4*)p0);
                const s16x4 hi = __builtin_amdgcn_ds_read_tr16_b64_v4i16((LAS s16x4*)(p0 + 4 * VS));
                af[ct] = __builtin_shufflevector(lo, hi, 0, 1, 2, 3, 4, 5, 6, 7);
            }
#pragma unroll
            for (int pt = 0; pt < 8; ++pt) {
                const bf16x8 bfr = *(const LAS bf16x8*)(lds + WT_OFF + (16 * pt + l15) * WSs + (32 * ks + 8 * g4) * 2);
#pragma unroll
                for (int ct = 0; ct < 2; ++ct) d[ct][pt] = __builtin_amdgcn_mfma_f32_16x16x32_bf16(af[ct], bfr, d[ct][pt], 0, 0, 0);
            }
        }
#pragma unroll
        for (int pt = 0; pt < 8; ++pt) {
            const int p = 16 * pt + l15; const float bs = b_s[g * 128 + p];
            bf16_t* rp = Z + ((size_t)chunk * 128 + p) * 4096 + g * 256 + c0 + 4 * g4;
#pragma unroll
            for (int ct = 0; ct < 2; ++ct) {
                const u32x2 uw = *(const u32x2*)(rp + 16 * ct);
                const f32x4 s = d[ct][pt] + bs;
                u32x2 o; o.x = cvt_pk_bf16(bf_lo(uw.x) * s[0], bf_hi(uw.x) * s[1]); o.y = cvt_pk_bf16(bf_lo(uw.y) * s[2], bf_hi(uw.y) * s[3]);
                *(u32x2*)(rp + 16 * ct) = o;
            }
        }
    }
}

__device__ __forceinline__ void attn_phase(LAS unsigned char* lds, const bf16_t* QKV, bf16_t* O, const float* sink, int G, int c) {
    constexpr int KS = 144, KBUF = 64 * KS, V_OFF = 2 * KBUF, NQB = 2;
    const int tid = threadIdx.x, lane = tid & 63, w = __builtin_amdgcn_readfirstlane(tid >> 6), l15 = lane & 15, g4 = lane >> 4, qq = l15 >> 2, pp = l15 & 3;
    const int which = tid >> 8, idx = tid & 255, lkey = idx >> 2, lcp = idx & 3;
    for (int u = c; u < BATCH * 64 * 4; u += G) {
        const int b = u >> 8, jh = (u >> 2) & 63, kvh = u & 3;
        const int hq = kvh * 4 + (w >> 1), qsub = (w & 1) * 32;
        const int q0 = jh * 64;
        const size_t rowbase = (size_t)b * SEQ + q0 + qsub;
        bf16x8 qf[NQB][2];
#pragma unroll
        for (int qb = 0; qb < NQB; ++qb)
#pragma unroll
            for (int ks = 0; ks < 2; ++ks) qf[qb][ks] = *(const bf16x8*)(QKV + (rowbase + qb * 16 + l15) * QKVD + hq * 64 + ks * 32 + g4 * 8);
        const float sk = sink[hq];
        float m_[NQB], l_[NQB]; f32x4 o[4][NQB];
#pragma unroll
        for (int qb = 0; qb < NQB; ++qb) { m_[qb] = sk; l_[qb] = (g4 == 0) ? 1.0f : 0.0f;
#pragma unroll
            for (int dt = 0; dt < 4; ++dt) o[dt][qb] = (f32x4){0.f, 0.f, 0.f, 0.f}; }
        const int tt_lo = (jh < 2) ? (2 - jh) : 0, tt_hi = (65 - jh < 4) ? (65 - jh) : 4, nlat = tt_hi - tt_lo + 1, ntiles = nlat + 4;
        const int lcol = (which ? 1280 : 1024) + kvh * 64 + lcp * 16;
#define TILE_ROW(i) ((i) < nlat ? ((size_t)b * SEQ + q0 - 128 + (tt_lo + (i)) * 64 + lkey) : ((size_t)MLAT + b * CTXL + ((i) - nlat) * 64 + lkey))
        u32x4 r0, r1;
        { const bf16_t* src = QKV + TILE_ROW(0) * QKVD + lcol; r0 = *(const u32x4*)src; r1 = *(const u32x4*)(src + 8);
          LAS unsigned char* dst = lds + which * V_OFF + lkey * KS + lcp * 32; *(LAS u32x4*)dst = r0; *(LAS u32x4*)(dst + 16) = r1; }
        __syncthreads();
        for (int it = 0; it < ntiles; ++it) {
            const bool more = (it + 1 < ntiles);
            if (more) { const bf16_t* src = QKV + TILE_ROW(it + 1) * QKVD + lcol; r0 = *(const u32x4*)src; r1 = *(const u32x4*)(src + 8); }
            const LAS unsigned char* Kb = lds + (it & 1) * KBUF; const LAS unsigned char* Vb = lds + V_OFF + (it & 1) * KBUF;
            f32x4 s[4][NQB];
#pragma unroll
            for (int kt = 0; kt < 4; ++kt) {
                const bf16x8 k0 = *(const LAS bf16x8*)(Kb + (kt * 16 + l15) * KS + g4 * 16), k1 = *(const LAS bf16x8*)(Kb + (kt * 16 + l15) * KS + 64 + g4 * 16);
#pragma unroll
                for (int qb = 0; qb < NQB; ++qb) {
                    f32x4 a = __builtin_amdgcn_mfma_f32_16x16x32_bf16(k0, qf[qb][0], (f32x4){0.f, 0.f, 0.f, 0.f}, 0, 0, 0);
                    s[kt][qb] = __builtin_amdgcn_mfma_f32_16x16x32_bf16(k1, qf[qb][1], a, 0, 0, 0);
                }
            }
            bf16x8 pf[NQB][2];
#pragma unroll
            for (int qb = 0; qb < NQB; ++qb) {
                float mx = -1e30f;
                if (it < nlat) {
                    const int qi = qsub + qb * 16 + l15, tt = tt_lo + it;
#pragma unroll
                    for (int kt = 0; kt < 4; ++kt)
#pragma unroll
                        for (int r = 0; r < 4; ++r) { const int dd = qi - tt * 64 - (kt * 16 + 4 * g4 + r); const bool ok = (dd <= 0) && (dd >= -256); s[kt][qb][r] = ok ? s[kt][qb][r] : -1e30f; }
                }
#pragma unroll
                for (int kt = 0; kt < 4; ++kt)
#pragma unroll
                    for (int r = 0; r < 4; ++r) mx = fmaxf(mx, s[kt][qb][r]);
                mx = fmaxf(mx, __shfl_xor(mx, 16)); mx = fmaxf(mx, __shfl_xor(mx, 32));
                const float mnew = fmaxf(m_[qb], mx), alpha = __builtin_amdgcn_exp2f((m_[qb] - mnew) * LOG2E);
                m_[qb] = mnew;
                float ps = 0.f;
#pragma unroll
                for (int kt = 0; kt < 4; ++kt)
#pragma unroll
                    for (int r = 0; r < 4; ++r) { const float p = __builtin_amdgcn_exp2f((s[kt][qb][r] - mnew) * LOG2E); ps += p; s[kt][qb][r] = p; }
                l_[qb] = l_[qb] * alpha + ps;
#pragma unroll
                for (int dt = 0; dt < 4; ++dt) o[dt][qb] *= alpha;
#pragma unroll
                for (int kk = 0; kk < 2; ++kk) {
                    u32x4 pw; pw.x = cvt_pk_bf16(s[2 * kk][qb][0], s[2 * kk][qb][1]); pw.y = cvt_pk_bf16(s[2 * kk][qb][2], s[2 * kk][qb][3]);
                    pw.z = cvt_pk_bf16(s[2 * kk + 1][qb][0], s[2 * kk + 1][qb][1]); pw.w = cvt_pk_bf16(s[2 * kk + 1][qb][2], s[2 * kk + 1][qb][3]);
                    pf[qb][kk] = __builtin_bit_cast(bf16x8, pw);
                }
            }
#pragma unroll
            for (int kk = 0; kk < 2; ++kk)
#pragma unroll
                for (int dt = 0; dt < 4; ++dt) {
                    const LAS unsigned char* p0 = Vb + (32 * kk + 4 * g4 + qq) * KS + (16 * dt + 4 * pp) * 2;
                    const s16x4 lo = __builtin_amdgcn_ds_read_tr16_b64_v4i16((LAS s16x4*)p0);
                    const s16x4 hi = __builtin_amdgcn_ds_read_tr16_b64_v4i16((LAS s16x4*)(p0 + 16 * KS));
                    const bf16x8 vf = __builtin_shufflevector(lo, hi, 0, 1, 2, 3, 4, 5, 6, 7);
#pragma unroll
                    for (int qb = 0; qb < NQB; ++qb) o[dt][qb] = __builtin_amdgcn_mfma_f32_16x16x32_bf16(vf, pf[qb][kk], o[dt][qb], 0, 0, 0);
                }
            if (more) { LAS unsigned char* dst = lds + which * V_OFF + ((it + 1) & 1) * KBUF + lkey * KS + lcp * 32; *(LAS u32x4*)dst = r0; *(LAS u32x4*)(dst + 16) = r1; }
            __syncthreads();
        }
#undef TILE_ROW
#pragma unroll
        for (int qb = 0; qb < NQB; ++qb) {
            float l = l_[qb]; l += __shfl_xor(l, 16); l += __shfl_xor(l, 32);
            const float inv = 1.0f / l;
            bf16_t* op = O + (rowbase + qb * 16 + l15) * D + hq * 64 + 4 * g4;
#pragma unroll
            for (int dt = 0; dt < 4; ++dt) { const f32x4 v = o[dt][qb] * inv; u32x2 wv; wv.x = cvt_pk_bf16(v[0], v[1]); wv.y = cvt_pk_bf16(v[2], v[3]); *(u32x2*)(op + 16 * dt) = wv; }
        }
    }
}

#define XB_TMO      128
#define XB_XCNT(j)  (256  + 64 * (j))
#define XB_XSUB(j)  (1280 + 64 * (j))
#define XB_XGEN(j)  (2304 + 64 * (j))
#define XB_TOP      3328
#define XB_TOPGEN   3392
#define XCD_BAR_WORDS 3456
#define XB_SPIN_CAP (1u << 18)

__device__ __forceinline__ unsigned xb_ld(unsigned* p)              { return __hip_atomic_load(p, __ATOMIC_RELAXED, __HIP_MEMORY_SCOPE_AGENT); }
__device__ __forceinline__ unsigned xb_add(unsigned* p, unsigned v) { return __hip_atomic_fetch_add(p, v, __ATOMIC_RELAXED, __HIP_MEMORY_SCOPE_AGENT); }
__device__ __forceinline__ unsigned xb_xcc_id() { return (unsigned)__builtin_amdgcn_s_getreg((3 << 11) | 20) & 0xFu; }
#define XB_SPIN(cond, bar) do { unsigned _sp = 0; while (cond) { __builtin_amdgcn_s_sleep(1); \
    if ((++_sp & 255u) == 0u) { if (xb_ld(&(bar)[XB_TMO])) break; if (_sp > XB_SPIN_CAP) { atomicAdd(&(bar)[XB_TMO], 1u); break; } } } } while (0)

struct XcdBarrier {
    unsigned* bar; unsigned x;
    volatile LAS unsigned* st;
};

__device__ __forceinline__ XcdBarrier xcd_barrier_post(unsigned* bar, volatile LAS unsigned* st) {
    XcdBarrier b; b.bar = bar; b.x = xb_xcc_id(); b.st = st;
    if (threadIdx.x == 0) (void)xb_add(&bar[XB_XCNT(b.x)], 1u);
    return b;
}
__device__ __forceinline__ void xcd_barrier_complete(unsigned* bar, unsigned x, unsigned& nloc, unsigned& nx) {
    const unsigned G = gridDim.x * gridDim.y * gridDim.z;
    unsigned sum, cnt, mine, sp = 0u;
    for (;;) {
        sum = 0u; cnt = 0u; mine = 0u;
#pragma unroll
        for (unsigned j = 0; j < 16; ++j) { const unsigned c = xb_ld(&bar[XB_XCNT(j)]); sum += c; cnt += (c > 0u) ? 1u : 0u; mine = (j == x) ? c : mine; }
        if (sum == G) break;
        __builtin_amdgcn_s_sleep(1);
        if ((++sp & 255u) == 0u) { if (xb_ld(&bar[XB_TMO])) break; if (sp > XB_SPIN_CAP) { atomicAdd(&bar[XB_TMO], 1u); break; } }
    }
    nloc = mine > 0u ? mine : 1u; nx = cnt > 0u ? cnt : 1u;
}

__device__ __forceinline__ void xcd_barrier(const XcdBarrier& b) {
    asm volatile("s_waitcnt vmcnt(0)" ::: "memory");
    __syncthreads();
    if (threadIdx.x == 0) {
        unsigned* bar = b.bar;
        __builtin_amdgcn_s_waitcnt(0);
        unsigned nloc = b.st[0], nx = b.st[1];
        if (nloc == 0u) { xcd_barrier_complete(bar, b.x, nloc, nx); b.st[0] = nloc; b.st[1] = nx; }
        const unsigned old = xb_add(&bar[XB_XSUB(b.x)], 1u);
        const unsigned gen = old / nloc;
        if (old + 1u == (gen + 1u) * nloc) {
            __builtin_amdgcn_fence(__ATOMIC_RELEASE, "agent");
            asm volatile("s_waitcnt vmcnt(0)" ::: "memory");
            const unsigned og = xb_add(&bar[XB_TOP], 1u);
            const unsigned tg = og / nx;
            if (og + 1u == (tg + 1u) * nx) xb_add(&bar[XB_TOPGEN], 1u);
            else XB_SPIN(xb_ld(&bar[XB_TOPGEN]) == tg, bar);
            __builtin_amdgcn_fence(__ATOMIC_ACQUIRE, "agent");
            xb_add(&bar[XB_XGEN(b.x)], 1u);
            asm volatile("s_waitcnt vmcnt(0)" ::: "memory");
        } else {
            XB_SPIN(xb_ld(&bar[XB_XGEN(b.x)]) == gen, bar);
            __builtin_amdgcn_fence(__ATOMIC_ACQUIRE, "agent");
            asm volatile("s_waitcnt vmcnt(0)" ::: "memory");
        }
    }
    __syncthreads();
}


constexpr int N_PHASES = 18;
__global__ void __launch_bounds__(512, 2) mega_fwd(Args args) {
    extern __shared__ __attribute__((aligned(16))) unsigned char lds_raw[];
    LAS unsigned char* lds = (LAS unsigned char*)lds_raw;
    cg::grid_group grid = cg::this_grid();
    const int tid = threadIdx.x, lane = tid & 63, wave = __builtin_amdgcn_readfirstlane(tid >> 6);
    const int G = gridDim.x, bx = blockIdx.x;
    const int gw = bx * 8 + wave, NGW = G * 8, gtid = bx * 512 + tid, NT = G * 512;
    unsigned char* ws = args.ws;
    float* modv = (float*)(ws + WS_MODV); float* ropec = (float*)(ws + WS_ROPEC); float* ropes = (float*)(ws + WS_ROPES); float* biasp = (float*)(ws + WS_BIASP);
    bf16_t* wsb = (bf16_t*)(ws + WS_WS); f32x2* stats = (f32x2*)(ws + WS_STATS); float* ctxbuf = (float*)(ws + WS_CTX);
    bf16_t* win_t = (bf16_t*)(ws + WS_WIN); bf16_t* wout_t = (bf16_t*)(ws + WS_WOUT); bf16_t* wqkv_t = (bf16_t*)(ws + WS_WQKV); bf16_t* wo_t = (bf16_t*)(ws + WS_WO);
    bf16_t* wup_t = (bf16_t*)(ws + WS_WUP); bf16_t* wdn_t = (bf16_t*)(ws + WS_WDN);
    bf16_t* YH = (bf16_t*)(ws + WS_YH); bf16_t* BIG = (bf16_t*)(ws + WS_BIG); bf16_t* OBUF = (bf16_t*)(ws + WS_OBUF);
    const float* norm_g = args.in[I_NORMG];
    volatile LAS unsigned* xst = (volatile LAS unsigned*)(lds + LDS_BYTES - 64);
    if (tid < 2) xst[tid] = 0u;
    __syncthreads();
    XcdBarrier xbar = xcd_barrier_post((unsigned*)(ws + WS_BAR), xst);
    const int lo = args.ph_lo, hi = args.ph_hi;
#ifndef PHMASK
#define PHMASK 0x3ffff
#endif
#define IN(k) (((PHMASK >> (k)) & 1) && lo <= (k) && (k) < hi)
#ifndef PROBE_DBL
#define PROBE_DBL 0
#endif
#define REP(k) for (int rep_ = 0; rep_ < 1 + ((PROBE_DBL >> (k)) & 1); ++rep_)
#define SEAM(k) do { if (IN(k) && IN((k) + 1)) { if ((k) == 0) { __syncthreads(); grid.sync(); } else xcd_barrier(xbar); } } while (0)

    if (IN(0)) REP(0) {
        __syncthreads();
        LAS float* sil = (LAS float*)(lds + 8 * 8448);
        for (int i = tid; i < 9 * 1024; i += 512) { const float v = (i < 8192) ? args.in[I_C][i] : args.in[I_CCTX][i - 8192]; sil[i] = v / (1.0f + __expf(-v)); }
        __syncthreads();
        LAS float* scr = (LAS float*)(lds + wave * 8448);
        constexpr int I_MOD = 192, I_WIN = 16 * 128, I_WOUT = 32 * 32, I_WQKV = 16 * 48, I_WO = 16 * 32, I_WUP = 16 * 176, I_WDN = 44 * 32;
        constexpr int NITEMS = I_MOD + I_WIN + I_WOUT + I_WQKV + I_WO + I_WUP + I_WDN;
        for (int it = gw; it < NITEMS; it += NGW) {
            int r = it;
            if (r < I_MOD) {
                const int layer = r / 96, col = (r % 96) * 64 + lane;
                const float* W = args.in[I_ADAW] + (size_t)layer * 1024 * 6144 + col;
                float acc[9];
#pragma unroll
                for (int b = 0; b < 9; ++b) acc[b] = 0.f;
                for (int k = 0; k < 1024; k += 4) {
                    const float w0 = W[(size_t)k * 6144], w1 = W[(size_t)(k + 1) * 6144], w2 = W[(size_t)(k + 2) * 6144], w3 = W[(size_t)(k + 3) * 6144];
#pragma unroll
                    for (int b = 0; b < 9; ++b) { const f32x4 sv = *(const LAS f32x4*)(sil + b * 1024 + k); acc[b] += sv[0] * w0 + sv[1] * w1 + sv[2] * w2 + sv[3] * w3; }
                }
                const float ab = args.in[I_ADAB][layer * 6144 + col];
#pragma unroll
                for (int b = 0; b < 9; ++b) modv[(size_t)(layer * 9 + b) * 6144 + col] = acc[b] + ab;
                continue;
            }
            r -= I_MOD;
            if (r < I_WIN) { transpose_item(args.in[I_AWIN], 1024, 4096, win_t, false, scr, r, lane); continue; } r -= I_WIN;
            if (r < I_WOUT) { transpose_item(args.in[I_AWOUT], 2048, 1024, wout_t, false, scr, r, lane); continue; } r -= I_WOUT;
            if (r < I_WQKV) { transpose_item(args.in[I_BWQKV], 1024, 1536, wqkv_t, true, scr, r, lane); continue; } r -= I_WQKV;
            if (r < I_WO) { transpose_item(args.in[I_BWO], 1024, 1024, wo_t, false, scr, r, lane); continue; } r -= I_WO;
            if (r < I_WUP) { transpose_item(args.in[I_FWUP], 1024, 5632, wup_t, false, scr, r, lane); continue; } r -= I_WUP;
            transpose_item(args.in[I_FWDN], 2816, 1024, wdn_t, false, scr, r, lane);
        }
        for (int i = gtid; i < 8 * 128 * 128 / 2; i += NT) { const f32x2 v = *(const f32x2*)(args.in[I_AWS] + 2 * i); ((unsigned*)wsb)[i] = cvt_pk_bf16(v.x, v.y); }
        for (int i = gtid; i < SEQ * 32; i += NT) {
            const int pos = i >> 5, f = i & 31; const float p = (f < 16) ? (float)(pos >> 6) : (float)(pos & 63);
            const float inv_freq = exp2f(-(float)(f & 15) * (13.287712379549449f / 16.0f));
            const float ang = p * inv_freq;
            double rev = (double)ang * 0.15915494309189535; rev -= floor(rev);
            ropec[i] = __builtin_amdgcn_cosf((float)rev); ropes[i] = __builtin_amdgcn_sinf((float)rev);
        }
        for (int i = gtid; i < QKVD; i += NT) biasp[qkv_dst_row(i)] = args.in[I_BBQKV][i];
    }
    SEAM(0);

    if (IN(1)) REP(1) {
        RowArgs A{}; A.xin_lat = args.in[I_X]; A.xin_ctx = args.in[I_CTX]; A.Y = nullptr;
        A.ng_pre = norm_g + 0 * D; A.hmod = modv; A.sh_off = 0; A.sc_off = D; A.H = YH; A.nrows = MALL;
        row_phase(A, gw, NGW, lane);
    }
    SEAM(1);

    if (IN(2)) REP(2) {
        pg8::Gemm g{YH, D, win_t, MALL, 4096, D}; pg8::StaticOrder S; S.init(MALL, 4096, G, bx);
        pg8::Epi<1> E{BIG, 4096, stats, nullptr, nullptr, nullptr};
        pg8::gemm_phase<pg8::Epi<1>, true, true>(lds, g, S, E);
    }
    SEAM(2);

    if (IN(3)) sgate_phase(lds, BIG, stats, wsb, args.in[I_ABS], args.in[I_ALNG], args.in[I_ALNB], G, bx);
    SEAM(3);

    if (IN(4)) REP(4) {
        pg8::Gemm g{BIG, 4096, wout_t, MALL, D, EW}; pg8::StaticOrder S; S.init(MALL, D, G, bx);
        pg8::Epi<2> E{YH, D, stats, nullptr, nullptr, nullptr};
        pg8::gemm_phase<pg8::Epi<2>, true, true>(lds, g, S, E);
    }
    SEAM(4);

#define LAYER_TAIL(LI, PH, NROWS, XIN_LAT, XIN_CTX)                                                                               \
    if (IN(PH)) {                                                                                                                \
        RowArgs A{}; A.xin_lat = (XIN_LAT); A.xin_ctx = (XIN_CTX); A.xout_lat = args.out; A.xout_ctx = ctxbuf;                   \
        A.Y = YH; A.stats = stats; A.gmod = modv + (LI) * 9 * 6144; A.gate_off = 2 * D; A.ng_post = norm_g + ((LI) * 4 + 1) * D; \
        A.ng_pre = norm_g + ((LI) * 4 + 2) * D; A.hmod = modv + (LI) * 9 * 6144; A.sh_off = 3 * D; A.sc_off = 4 * D; A.H = YH; A.nrows = (NROWS); \
        row_phase(A, gw, NGW, lane);                                                                                             \
    }                                                                                                                            \
    SEAM(PH);                                                                                                                    \
    if (IN((PH) + 1)) REP((PH) + 1) {                                                                                                     \
        pg8::Gemm g{YH, D, wup_t, (NROWS), 2 * FF, D}; pg8::StaticOrder S; S.init((NROWS), 2 * FF, G, bx);                       \
        pg8::Epi<0> E{BIG, 2 * FF, nullptr, nullptr, nullptr, nullptr};                                                          \
        pg8::gemm_phase<pg8::Epi<0>, true, true>(lds, g, S, E);                                                                  \
    }                                                                                                                            \
    SEAM((PH) + 1);                                                                                                              \
    if (IN((PH) + 2)) conv_phase(BIG, args.in[I_FCONVW] + (LI) * 3 * FF, args.in[I_FCONVB] + (LI) * FF, (NROWS), gtid, NT);      \
    SEAM((PH) + 2);                                                                                                              \
    if (IN((PH) + 3)) REP((PH) + 3) {                                                                                                     \
        pg8::Gemm g{BIG + FF, 2 * FF, wdn_t, (NROWS), D, FF}; pg8::StaticOrder S; S.init((NROWS), D, G, bx);                     \
        pg8::Epi<2> E{YH, D, stats, nullptr, nullptr, nullptr};                                                                  \
        pg8::gemm_phase<pg8::Epi<2>, true, true>(lds, g, S, E);                                                                  \
    }                                                                                                                            \
    SEAM((PH) + 3);

    LAYER_TAIL(0, 5, MALL, args.in[I_X], args.in[I_CTX])

    if (IN(9)) {
        RowArgs A{}; A.xin_lat = args.out; A.xin_ctx = ctxbuf; A.xout_lat = args.out; A.xout_ctx = ctxbuf;
        A.Y = YH; A.stats = stats; A.gmod = modv; A.gate_off = 5 * D; A.ng_post = norm_g + 3 * D;
        A.ng_pre = norm_g + 4 * D; A.hmod = modv + 9 * 6144; A.sh_off = 0; A.sc_off = D; A.H = YH; A.nrows = MALL;
        row_phase(A, gw, NGW, lane);
        LAS float* scr = (LAS float*)(lds + wave * 8448);
        constexpr int I_WUP = 16 * 176, I_WDN = 44 * 32;
        for (int it = gw; it < I_WUP + I_WDN; it += NGW) {
            if (it < I_WUP) transpose_item(args.in[I_FWUP] + (size_t)D * 2 * FF, 1024, 5632, wup_t, false, scr, it, lane);
            else transpose_item(args.in[I_FWDN] + (size_t)FF * D, 2816, 1024, wdn_t, false, scr, it - I_WUP, lane);
        }
    }
    SEAM(9);

    if (IN(10)) REP(10) {
        pg8::Gemm g{YH, D, wqkv_t, MALL, QKVD, D}; pg8::StaticOrder S; S.init(MALL, QKVD, G, bx);
        pg8::Epi<3> E{BIG, QKVD, nullptr, biasp, ropec, ropes};
        pg8::gemm_phase<pg8::Epi<3>, true, true>(lds, g, S, E);
    }
    SEAM(10);

    if (IN(11)) REP(11) attn_phase(lds, BIG, OBUF, args.in[I_BSINK], G, bx);
    SEAM(11);

    if (IN(12)) REP(12) {
        pg8::Gemm g{OBUF, D, wo_t, MLAT, D, D}; pg8::StaticOrder S; S.init(MLAT, D, G, bx);
        pg8::Epi<2> E{YH, D, stats, nullptr, nullptr, nullptr};
        pg8::gemm_phase<pg8::Epi<2>, true, true>(lds, g, S, E);
    }
    SEAM(12);

    LAYER_TAIL(1, 13, MLAT, args.out, ctxbuf)

    if (IN(17)) {
        RowArgs A{}; A.xin_lat = args.out; A.xin_ctx = ctxbuf; A.xout_lat = args.out; A.xout_ctx = ctxbuf;
        A.Y = YH; A.stats = stats; A.gmod = modv + 9 * 6144; A.gate_off = 5 * D; A.ng_post = norm_g + 7 * D;
        A.H = nullptr; A.nrows = MLAT;
        row_phase(A, gw, NGW, lane);
    }
#undef IN
#undef SEAM
}

extern "C" void kernel_launch(void* const* d_in, const int* in_sizes, int n_in, void* d_out, int out_size, void* d_ws, size_t ws_size, hipStream_t stream) {
    static int grid = 0;
    if (grid == 0) {
        if (n_in != 21 || ws_size < WS_END) { fprintf(stderr, "kernel_launch: expected 21 inputs and >= %zu bytes of workspace (got %d, %zu)\n", (size_t)WS_END, n_in, ws_size); grid = -1; return; }
        int dev = 0, cus = 0, per_cu = 0;
        hipGetDevice(&dev); hipDeviceGetAttribute(&cus, hipDeviceAttributeMultiprocessorCount, dev);
        if (hipFuncSetAttribute((const void*)mega_fwd, hipFuncAttributeMaxDynamicSharedMemorySize, LDS_BYTES) != hipSuccess) { fprintf(stderr, "kernel_launch: hipFuncSetAttribute failed\n"); grid = -1; return; }
        if (hipOccupancyMaxActiveBlocksPerMultiprocessor(&per_cu, (const void*)mega_fwd, 512, LDS_BYTES) != hipSuccess || per_cu < 1) { fprintf(stderr, "kernel_launch: occupancy query says %d\n", per_cu); per_cu = 1; }
        (void)hipGetLastError();
        grid = cus * 1;
    }
    if (grid < 0) return;
    Args a{};
    for (int i = 0; i < 21; ++i) a.in[i] = (const float*)d_in[i];
    a.out = (float*)d_out; a.ws = (unsigned char*)d_ws;
    (void)hipMemsetAsync((unsigned char*)d_ws + WS_BAR, 0, 16384, stream);
#if MK_PER_PHASE_LAUNCH
    for (int p = 0; p < N_PHASES; ++p) { a.ph_lo = p; a.ph_hi = p + 1; hipLaunchKernelGGL(mega_fwd, dim3(grid), dim3(512), LDS_BYTES, stream, a); }
#else
    a.ph_lo = 0; a.ph_hi = N_PHASES;
    void* kargs[] = {&a};
    hipError_t e = hipLaunchCooperativeKernel((const void*)mega_fwd, dim3(grid), dim3(512), kargs, LDS_BYTES, stream);
    if (e != hipSuccess) fprintf(stderr, "cooperative launch failed: %s (grid %d)\n", hipGetErrorString(e), grid);
#endif
}
```
